# Optimizing an MI355X kernel written in HIP

```python
import math
import jax
import jax.numpy as jnp
from jax import lax
import numpy as np

D_MODEL = 1024
BATCH = 8
SEQ = 2048
DEPTH = 4
DEC_BATCH = 32
DEC_SEQ = 4
PAST_LEN = 8192
PAGE_SIZE = 128

N_MIXERS = 3
N_A_LAYERS = len(range(0, DEPTH, N_MIXERS))
N_B_LAYERS = len(range(1, DEPTH, N_MIXERS))
N_C_LAYERS = len(range(2, DEPTH, N_MIXERS))
NORM_EPS = 1e-6
NEG_BIG = -1e30

A_HEADS = 8
A_DK = 128
A_DV = D_MODEL // A_HEADS
A_WIDTH = A_HEADS * A_DV
A_CHUNK = 32
A_IN = 2 * A_HEADS * A_DK + 2 * A_WIDTH
A_EXP_CLIP = 60.0

B_HEADS = 8
B_HEAD_DIM = D_MODEL // B_HEADS
B_WIDTH = B_HEADS * B_HEAD_DIM
B_GROUPS = ((128, 1), (512, 4), (2048, 16))
B_BLOCK = 128
B_IN = 3 * len(B_GROUPS) * B_WIDTH + B_WIDTH
ROPE_THETA = 10000.0

C_WIDTH = D_MODEL
C_GROUP_CH = 16
C_GROUPS = C_WIDTH // C_GROUP_CH
C_STATE = 64
C_IN = 2 * C_WIDTH
C_MAX_RE = -1e-4

kernel_name = 'hybrid_hgrn2_dilswa_s5_decode_step'


def rms_norm(x, w):
    xf = x.astype(jnp.float32)
    y = xf * lax.rsqrt(jnp.mean(xf * xf, axis=-1, keepdims=True) + NORM_EPS)
    return (y * w.astype(jnp.float32)).astype(x.dtype)


def apply_rope(x, pos):
    half = x.shape[-1] // 2
    inv_freq = ROPE_THETA ** (-jnp.arange(half, dtype=jnp.float32) / half)
    ang = pos[:, None] * inv_freq[None, :]
    cos = jnp.cos(ang)[None, :, None, :]
    sin = jnp.sin(ang)[None, :, None, :]
    xf = x.astype(jnp.float32)
    x1, x2 = xf[..., :half], xf[..., half:]
    return jnp.concatenate([x1 * cos - x2 * sin, x2 * cos + x1 * sin], axis=-1).astype(x.dtype)


def hgrn2_recurrence(q, k, v, log_f, state0):
    bn, t, h, dk = q.shape
    dv = v.shape[-1]
    c = A_CHUNK if t % A_CHUNK == 0 else t
    nc = t // c

    def chunks(a):
        return a.reshape(bn, nc, c, h, a.shape[-1]).transpose(1, 0, 3, 2, 4)

    causal = jnp.tril(jnp.ones((c, c), dtype=bool))

    def step(s, inp):
        qc, kc, vc, gc = inp
        b = jnp.cumsum(gc, axis=-2)
        diff = jnp.where(causal[:, :, None], b[..., :, None, :] - b[..., None, :, :], NEG_BIG)
        scores = jnp.einsum('bhtk,bhsk,bhtsk->bhts', qc, kc, jnp.exp(diff))
        o = scores @ vc + jnp.einsum('bhtk,bhkv->bhtv', qc * jnp.exp(b), s)
        b_last = b[..., -1:, :]
        s = jnp.exp(b_last[..., 0, :])[..., None] * s + jnp.einsum('bhsk,bhsv->bhkv', kc * jnp.exp(b_last - b), vc)
        return s, o

    s0 = jnp.zeros((bn, h, dk, dv), jnp.float32) if state0 is None else state0.astype(jnp.float32)
    s_last, o = lax.scan(step, s0, (chunks(q), chunks(k), chunks(v), chunks(log_f)))
    o = o.transpose(1, 0, 3, 2, 4).reshape(bn, t, h, dv)
    return o, s_last


def hgrn2_mixer(h, w_in, lower_bound, onorm_w, w_out, state0):
    bn, t, _ = h.shape
    f32 = jnp.float32
    proj = h @ w_in
    nq = A_HEADS * A_DK
    q = jax.nn.silu(proj[..., :nq].astype(f32)).reshape(bn, t, A_HEADS, A_DK)
    zf = proj[..., nq:2 * nq].astype(f32).reshape(bn, t, A_HEADS, A_DK)
    v = proj[..., 2 * nq:2 * nq + A_WIDTH].astype(f32).reshape(bn, t, A_HEADS, A_DV)
    gate = proj[..., 2 * nq + A_WIDTH:]
    lb = lower_bound.astype(f32).reshape(A_HEADS, A_DK)
    log_f = jax.nn.log_sigmoid(zf) + jnp.log1p(lb * jnp.exp(jnp.minimum(-zf, A_EXP_CLIP)))
    k = (1.0 - lb) * jax.nn.sigmoid(-zf)
    o, s_last = hgrn2_recurrence(q, k, v, log_f, state0)
    o = rms_norm(o, onorm_w.reshape(A_HEADS, A_DV))
    o = o.reshape(bn, t, A_WIDTH).astype(h.dtype) * jax.nn.silu(gate)
    return o @ w_out, s_last


def dilated_group_prompt(q, k, v, dil, n_keys):
    bn, s, h, hd = q.shape
    n = s // dil
    nb = -(-n // B_BLOCK)
    npad = nb * B_BLOCK

    def to_res(a):
        a = a.reshape(bn, n, dil, h, hd).transpose(0, 2, 1, 3, 4).reshape(bn * dil, n, h, hd)
        a = jnp.pad(a, ((0, 0), (0, npad - n), (0, 0), (0, 0)))
        return a.reshape(bn * dil, nb, B_BLOCK, h, hd)

    def with_prev(a):
        prev = jnp.pad(a[:, :-1], ((0, 0), (1, 0), (0, 0), (0, 0), (0, 0)))
        return jnp.concatenate([prev, a], axis=2)

    def from_res(a):
        rest = a.shape[3:]
        a = a.reshape((bn, dil, npad) + rest)[:, :, :n]
        return jnp.swapaxes(a, 1, 2).reshape((bn, s) + rest)

    qb = to_res(q)
    kk = with_prev(to_res(k))
    vv = with_prev(to_res(v))
    a_idx = jnp.arange(B_BLOCK)[:, None]
    c_idx = jnp.arange(2 * B_BLOCK)[None, :]
    rel = a_idx - c_idx + B_BLOCK
    blk = jnp.arange(nb)[:, None, None]
    valid = (rel >= 0) & (rel <= n_keys) & (blk * B_BLOCK + c_idx - B_BLOCK >= 0)
    sc = jnp.einsum('zjqhd,zjkhd->zjhqk', qb, kk).astype(jnp.float32) * (hd ** -0.5)
    sc = jnp.where(valid[None, :, None], sc, NEG_BIG)
    lse = jax.nn.logsumexp(sc, axis=-1)
    p = jnp.exp(sc - lse[..., None])
    o = jnp.einsum('zjhqk,zjkhd->zjqhd', p.astype(vv.dtype), vv).astype(jnp.float32)
    return from_res(o), from_res(jnp.swapaxes(lse, 2, 3))


def dilated_group_sample(q, k, v, buf, dil, n_keys, window):
    db, t, h, hd = q.shape
    lb = buf.shape[1]
    k_all = jnp.concatenate([buf[:, :, 0], k], axis=1)
    v_all = jnp.concatenate([buf[:, :, 1], v], axis=1)
    idx = lb + jnp.arange(t)[:, None] - dil * jnp.arange(n_keys + 1)[None, :]
    valid = idx >= 0
    flat = jnp.maximum(idx, 0).reshape(-1)
    kg = jnp.take(k_all, flat, axis=1).reshape(db, t, n_keys + 1, h, hd)
    vg = jnp.take(v_all, flat, axis=1).reshape(db, t, n_keys + 1, h, hd)
    sc = jnp.einsum('bthd,btkhd->bthk', q, kg).astype(jnp.float32) * (hd ** -0.5)
    sc = jnp.where(valid[None, :, None, :], sc, NEG_BIG)
    lse = jax.nn.logsumexp(sc, axis=-1)
    p = jnp.exp(sc - lse[..., None])
    o = jnp.einsum('bthk,btkhd->bthd', p.astype(vg.dtype), vg).astype(jnp.float32)
    keep = min(window, k_all.shape[1])
    new_buf = jnp.stack([k_all[:, -keep:], v_all[:, -keep:]], axis=2)
    return o, lse, new_buf


def dilated_mixer(h, w_in, w_out, pos, bufs):
    bn, t, _ = h.shape
    proj = h @ w_in
    outs, lses, new_bufs = [], [], []
    for gi, (window, dil) in enumerate(B_GROUPS):
        base = gi * 3 * B_WIDTH
        q, k, v = [proj[..., base + m * B_WIDTH: base + (m + 1) * B_WIDTH].reshape(bn, t, B_HEADS, B_HEAD_DIM)
                   for m in range(3)]
        q = apply_rope(q, pos)
        k = apply_rope(k, pos)
        n_keys = window // dil
        if bufs is None:
            o, lse = dilated_group_prompt(q, k, v, dil, n_keys)
            keep = min(window, t)
            nbuf = jnp.stack([k[:, t - keep:], v[:, t - keep:]], axis=2)
        else:
            o, lse, nbuf = dilated_group_sample(q, k, v, bufs[gi], dil, n_keys, window)
        outs.append(o)
        lses.append(lse)
        new_bufs.append(nbuf)
    wts = jax.nn.softmax(jnp.stack(lses, axis=0), axis=0)
    o = jnp.sum(wts[..., None] * jnp.stack(outs, axis=0), axis=0)
    gate = proj[..., 3 * len(B_GROUPS) * B_WIDTH:]
    o = o.reshape(bn, t, B_WIDTH).astype(h.dtype) * jax.nn.silu(gate)
    return o @ w_out, new_bufs


def s5_mixer(h, w_in, a_re, a_im, b_re, b_im, c_re, c_im, d_skip, log_dt, w_glu, b_glu, w_out, state0):
    bn, t, _ = h.shape
    f32 = jnp.float32
    proj = h @ w_in
    u = proj[..., :C_WIDTH].astype(f32)
    gate = proj[..., C_WIDTH:]
    ug = u.reshape(bn, t, C_GROUPS, C_GROUP_CH)
    lam_re = jnp.minimum(a_re.astype(f32), C_MAX_RE)
    lam_im = a_im.astype(f32)
    dt = jnp.exp(log_dt.astype(f32))[:, None]
    mag = jnp.exp(lam_re * dt)
    bar_re = mag * jnp.cos(lam_im * dt)
    bar_im = mag * jnp.sin(lam_im * dt)
    den = lam_re * lam_re + lam_im * lam_im
    xr = bar_re - 1.0
    coef_re = (xr * lam_re + bar_im * lam_im) / den
    coef_im = (bar_im * lam_re - xr * lam_im) / den
    br, bi = b_re.astype(f32), b_im.astype(f32)
    bbar_re = coef_re[..., None] * br - coef_im[..., None] * bi
    bbar_im = coef_re[..., None] * bi + coef_im[..., None] * br
    bu_re = jnp.einsum('btgc,gpc->btgp', ug, bbar_re)
    bu_im = jnp.einsum('btgc,gpc->btgp', ug, bbar_im)
    if state0 is not None:
        s_re = state0[..., 0].astype(f32)
        s_im = state0[..., 1].astype(f32)
        bu_re = bu_re.at[:, 0].add(bar_re * s_re - bar_im * s_im)
        bu_im = bu_im.at[:, 0].add(bar_re * s_im + bar_im * s_re)
    a_re_t = jnp.broadcast_to(bar_re, (1, t) + bar_re.shape)
    a_im_t = jnp.broadcast_to(bar_im, (1, t) + bar_im.shape)

    def combine(e1, e2):
        a1r, a1i, b1r, b1i = e1
        a2r, a2i, b2r, b2i = e2
        return (a2r * a1r - a2i * a1i, a2r * a1i + a2i * a1r,
                a2r * b1r - a2i * b1i + b2r, a2r * b1i + a2i * b1r + b2i)

    _, _, xs_re, xs_im = lax.associative_scan(combine, (a_re_t, a_im_t, bu_re, bu_im), axis=1)
    y = (jnp.einsum('gcp,btgp->btgc', c_re.astype(f32), xs_re)
         - jnp.einsum('gcp,btgp->btgc', c_im.astype(f32), xs_im))
    y = y.reshape(bn, t, C_WIDTH) + d_skip.astype(f32) * u
    y = jax.nn.gelu(y)
    y = y * jax.nn.sigmoid(y @ w_glu.astype(f32) + b_glu.astype(f32))
    y = y.astype(h.dtype) * jax.nn.silu(gate)
    new_state = jnp.stack([xs_re[:, -1], xs_im[:, -1]], axis=-1)
    return y @ w_out, new_state


def setup_inputs(seed: int = 0) -> dict:
    key = jax.random.key(seed)
    ks = iter(jax.random.split(key, 40))
    f32 = jnp.float32

    def nrm(shape, scale=1.0):
        return scale * jax.random.normal(next(ks), shape, f32)

    def buf_len(w):
        return min(w, PAST_LEN)

    kv_shape = lambda w: (N_B_LAYERS, DEC_BATCH, buf_len(w), 2, B_HEADS, B_HEAD_DIM)
    return {
        'x_prompt': nrm((BATCH, SEQ, D_MODEL)),
        'x_sample': nrm((DEC_BATCH, DEC_SEQ, D_MODEL)),
        'state_hgrn': nrm((N_A_LAYERS, DEC_BATCH, A_HEADS, A_DK, A_DV), 0.5),
        'cache_kv_w128': nrm(kv_shape(B_GROUPS[0][0])),
        'cache_kv_w512': nrm(kv_shape(B_GROUPS[1][0])),
        'cache_kv_w2048': nrm(kv_shape(B_GROUPS[2][0])),
        'state_s5': nrm((N_C_LAYERS, DEC_BATCH, C_GROUPS, C_STATE, 2), 0.2),
        'norm_w': 1.0 + nrm((DEPTH, D_MODEL), 0.02),
        'final_norm_w': 1.0 + nrm((D_MODEL,), 0.02),
        'a_w_in': nrm((N_A_LAYERS, D_MODEL, A_IN), D_MODEL ** -0.5),
        'a_lb_logits': nrm((N_A_LAYERS, A_HEADS * A_DK), 1.0),
        'a_onorm_w': 1.0 + nrm((N_A_LAYERS, A_WIDTH), 0.02),
        'a_w_out': nrm((N_A_LAYERS, A_WIDTH, D_MODEL), A_WIDTH ** -0.5),
        'b_w_in': nrm((N_B_LAYERS, D_MODEL, B_IN), D_MODEL ** -0.5),
        'b_w_out': nrm((N_B_LAYERS, B_WIDTH, D_MODEL), B_WIDTH ** -0.5),
        'c_w_in': nrm((N_C_LAYERS, D_MODEL, C_IN), D_MODEL ** -0.5),
        'c_a_re': -0.5 + nrm((N_C_LAYERS, C_GROUPS, C_STATE), 0.01),
        'c_a_im': jnp.pi * jnp.arange(C_STATE, dtype=f32) + nrm((N_C_LAYERS, C_GROUPS, C_STATE), 0.01),
        'c_b_re': nrm((N_C_LAYERS, C_GROUPS, C_STATE, C_GROUP_CH), (2.0 * C_GROUP_CH) ** -0.5),
        'c_b_im': nrm((N_C_LAYERS, C_GROUPS, C_STATE, C_GROUP_CH), (2.0 * C_GROUP_CH) ** -0.5),
        'c_c_re': nrm((N_C_LAYERS, C_GROUPS, C_GROUP_CH, C_STATE), (2.0 * C_STATE) ** -0.5),
        'c_c_im': nrm((N_C_LAYERS, C_GROUPS, C_GROUP_CH, C_STATE), (2.0 * C_STATE) ** -0.5),
        'c_d': nrm((N_C_LAYERS, C_WIDTH), 1.0),
        'c_log_dt': jax.random.uniform(next(ks), (N_C_LAYERS, C_GROUPS), f32, math.log(0.001), math.log(0.1)),
        'c_w_glu': nrm((N_C_LAYERS, C_WIDTH, C_WIDTH), C_WIDTH ** -0.5),
        'c_b_glu': nrm((N_C_LAYERS, C_WIDTH), 0.01),
        'c_w_out': nrm((N_C_LAYERS, C_WIDTH, D_MODEL), C_WIDTH ** -0.5),
    }


def reference(x_prompt, x_sample, state_hgrn, cache_kv_w128, cache_kv_w512, cache_kv_w2048, state_s5,
              norm_w, final_norm_w, a_w_in, a_lb_logits, a_onorm_w, a_w_out, b_w_in, b_w_out,
              c_w_in, c_a_re, c_a_im, c_b_re, c_b_im, c_c_re, c_c_im, c_d, c_log_dt, c_w_glu, c_b_glu, c_w_out):
    f32 = jnp.float32
    pos_p = jnp.arange(x_prompt.shape[1], dtype=f32)
    pos_s = PAST_LEN + jnp.arange(x_sample.shape[1], dtype=f32)
    p_lb = jax.nn.softmax(a_lb_logits.astype(f32), axis=0)
    lower_bounds = jnp.cumsum(p_lb, axis=0) - p_lb[0:1]
    caches = (cache_kv_w128, cache_kv_w512, cache_kv_w2048)
    xp, xs = x_prompt, x_sample
    hgrn_p, hgrn_s, s5_p, s5_s = [], [], [], []
    kv_p = [[] for _ in B_GROUPS]
    kv_s = [[] for _ in B_GROUPS]
    for layer in range(DEPTH):
        kind, j = layer % N_MIXERS, layer // N_MIXERS
        hp = rms_norm(xp, norm_w[layer])
        hs = rms_norm(xs, norm_w[layer])
        if kind == 0:
            wts = (a_w_in[j], lower_bounds[j], a_onorm_w[j], a_w_out[j])
            dp, st = hgrn2_mixer(hp, *wts, None)
            hgrn_p.append(st)
            ds, st = hgrn2_mixer(hs, *wts, state_hgrn[j])
            hgrn_s.append(st)
        elif kind == 1:
            dp, bufs = dilated_mixer(hp, b_w_in[j], b_w_out[j], pos_p, None)
            for g in range(len(B_GROUPS)):
                kv_p[g].append(bufs[g])
            ds, bufs = dilated_mixer(hs, b_w_in[j], b_w_out[j], pos_s, [cc[j] for cc in caches])
            for g in range(len(B_GROUPS)):
                kv_s[g].append(bufs[g])
        else:
            wts = (c_w_in[j], c_a_re[j], c_a_im[j], c_b_re[j], c_b_im[j], c_c_re[j], c_c_im[j],
                   c_d[j], c_log_dt[j], c_w_glu[j], c_b_glu[j], c_w_out[j])
            dp, st = s5_mixer(hp, *wts, None)
            s5_p.append(st)
            ds, st = s5_mixer(hs, *wts, state_s5[j])
            s5_s.append(st)
        xp = xp + dp
        xs = xs + ds
    y_prompt = rms_norm(xp, final_norm_w)
    y_sample = rms_norm(xs, final_norm_w)
    new_hgrn_prompt = jnp.stack(hgrn_p, axis=0)
    new_hgrn_sample = jnp.stack(hgrn_s, axis=0)
    new_kv128_prompt = jnp.stack(kv_p[0], axis=0)
    new_kv128_sample = jnp.stack(kv_s[0], axis=0)
    new_kv512_prompt = jnp.stack(kv_p[1], axis=0)
    new_kv512_sample = jnp.stack(kv_s[1], axis=0)
    new_kv2048_prompt = jnp.stack(kv_p[2], axis=0)
    new_kv2048_sample = jnp.stack(kv_s[2], axis=0)
    new_s5_prompt = jnp.stack(s5_p, axis=0)
    new_s5_sample = jnp.stack(s5_s, axis=0)
    return (y_prompt, y_sample, new_hgrn_prompt, new_hgrn_sample, new_kv128_prompt, new_kv128_sample,
            new_kv512_prompt, new_kv512_sample, new_kv2048_prompt, new_kv2048_sample,
            new_s5_prompt, new_s5_sample)
```

```cpp
#include <hip/hip_runtime.h>
#include <hip/hip_cooperative_groups.h>
#include <cstdio>
namespace cg = cooperative_groups;

#ifndef MK_MULTI
#define MK_MULTI 0
#endif

#ifndef HG_NP
#define HG_NP 1
#endif
#ifndef HG_NS
#define HG_NS 256
#endif
#define LAS __attribute__((address_space(3)))
typedef unsigned short u16;
typedef short bf16x8 __attribute__((ext_vector_type(8)));
typedef short s4 __attribute__((ext_vector_type(4)));
typedef float f32x4 __attribute__((ext_vector_type(4)));
typedef float f32x2 __attribute__((ext_vector_type(2)));
typedef unsigned u32x4 __attribute__((ext_vector_type(4)));
typedef unsigned u32x2 __attribute__((ext_vector_type(2)));

constexpr int D = 1024;
constexpr int MP = 16384;
constexpr int MS = 128;
constexpr int MALL = MP + MS;
constexpr int MPAD = 16640;
constexpr int SEQ = 2048;
constexpr int PAST = 8192;
constexpr int LDS_BYTES = 147456;

constexpr size_t AL(size_t x) { return (x + 255) & ~(size_t)255; }
constexpr size_t ACT_BF = (size_t)MPAD * D * 2;
constexpr size_t ACT_F32 = (size_t)MPAD * D * 4;
constexpr size_t WS_WT_A_IN = 0;
constexpr size_t WS_WT_A_OUT = WS_WT_A_IN + (size_t)2 * 4096 * 1024 * 2;
constexpr size_t WS_WT_B_IN = WS_WT_A_OUT + (size_t)2 * 1024 * 1024 * 2;
constexpr size_t WS_WT_B_OUT = WS_WT_B_IN + (size_t)10240 * 1024 * 2;
constexpr size_t WS_WT_C_IN = WS_WT_B_OUT + (size_t)1024 * 1024 * 2;
constexpr size_t WS_WT_C_GLU = WS_WT_C_IN + (size_t)2048 * 1024 * 2;
constexpr size_t WS_WT_C_OUT = WS_WT_C_GLU + (size_t)1024 * 1024 * 2;
constexpr size_t WS_X = WS_WT_C_OUT + (size_t)1024 * 1024 * 2;
constexpr size_t WS_H = WS_X + ACT_F32;
constexpr size_t WS_O = WS_H + ACT_BF;
constexpr size_t WS_GT = WS_O + ACT_BF;
constexpr size_t WS_Q = WS_GT + ACT_BF;
constexpr size_t WS_K = WS_Q + 3 * ACT_BF;
constexpr size_t WS_V = WS_K + 3 * ACT_BF;
constexpr size_t WS_G = WS_V + 3 * ACT_BF;
constexpr size_t WS_OG = WS_G + ACT_F32;
constexpr size_t WS_LSE = WS_OG + 3 * ACT_BF;
constexpr size_t WS_KVB = WS_LSE + AL((size_t)3 * MP * 8 * 4);
constexpr size_t WS_SST = WS_KVB + (size_t)128 * 8 * 16384 * 4;
constexpr size_t WS_DEC = WS_SST + (size_t)128 * 8 * 16384 * 4;
constexpr size_t WS_RCS = WS_DEC + AL((size_t)128 * 8 * 128 * 4);
constexpr size_t WS_LB = WS_RCS + AL((size_t)2052 * 64 * 8);
constexpr size_t WS_LAM = WS_LB + AL(2 * 1024 * 4);
constexpr size_t WS_SB5 = WS_LAM + AL(64 * 64 * 8);
constexpr size_t WS_SC5 = WS_SB5 + AL(64 * 8 * 64 * 4 * 2);
constexpr size_t WS_SSQ = WS_SC5 + AL(64 * 4 * 64 * 8 * 2);
constexpr size_t WS_BAR = WS_SSQ + AL((size_t)MPAD * 16 * 4);
constexpr size_t WS_END = WS_BAR + 16384;

constexpr size_t OUT_YP = 0;
constexpr size_t OUT_YS = OUT_YP + (size_t)MP * D;
constexpr size_t OUT_HGP = OUT_YS + (size_t)MS * D;
constexpr size_t OUT_HGS = OUT_HGP + (size_t)2 * 8 * 8 * 16384;
constexpr size_t OUT_KV128P = OUT_HGS + (size_t)2 * 32 * 8 * 16384;
constexpr size_t OUT_KV128S = OUT_KV128P + (size_t)8 * 128 * 2048;
constexpr size_t OUT_KV512P = OUT_KV128S + (size_t)32 * 128 * 2048;
constexpr size_t OUT_KV512S = OUT_KV512P + (size_t)8 * 512 * 2048;
constexpr size_t OUT_KV2048P = OUT_KV512S + (size_t)32 * 512 * 2048;
constexpr size_t OUT_KV2048S = OUT_KV2048P + (size_t)8 * 2048 * 2048;
constexpr size_t OUT_S5P = OUT_KV2048S + (size_t)32 * 2048 * 2048;
constexpr size_t OUT_S5S = OUT_S5P + (size_t)8 * 64 * 64 * 2;
constexpr size_t OUT_END = OUT_S5S + (size_t)32 * 64 * 64 * 2;

struct Params {
    const float* in[27];
    float* out;
    unsigned char* ws;
    int ph_lo, ph_hi;
    int tid, bid, nb, pad_;
};

typedef const __attribute__((address_space(4))) Params* KargPtr;
struct Ctx {
    KargPtr kp; int tid, bid, nb;
    __device__ __forceinline__ const float* in(int i) const { return kp->in[i]; }
    __device__ __forceinline__ float* out() const { return kp->out; }
    __device__ __forceinline__ unsigned char* ws() const { return kp->ws; }
};
__device__ __forceinline__ unsigned cvt_pk_bf16(float lo, float hi) { unsigned r; asm volatile("v_cvt_pk_bf16_f32 %0, %1, %2" : "=v"(r) : "v"(lo), "v"(hi)); return r; }
__device__ __forceinline__ u16 f2bf(float f) { return (u16)(cvt_pk_bf16(f, 0.f) & 0xffffu); }
__device__ __forceinline__ float bf2f(u16 b) { return __uint_as_float(((unsigned)b) << 16); }
__device__ __forceinline__ float bflo(unsigned w) { return __uint_as_float(w << 16); }
__device__ __forceinline__ float bfhi(unsigned w) { return __uint_as_float(w & 0xffff0000u); }
__device__ __forceinline__ float rcpf_(float x) { return __builtin_amdgcn_rcpf(x); }
__device__ __forceinline__ float exp2f_(float x) { return __builtin_amdgcn_exp2f(x); }
__device__ __forceinline__ float expf_(float x) { return __builtin_amdgcn_exp2f(x * 1.4426950408889634f); }
__device__ __forceinline__ float logf_(float x) { return __builtin_amdgcn_logf(x) * 0.6931471805599453f; }
__device__ __forceinline__ float sigmoidf_(float x) { return rcpf_(1.0f + expf_(-x)); }
__device__ __forceinline__ float siluf_(float x) { return x * rcpf_(1.0f + expf_(-x)); }
__device__ __forceinline__ float geluf_(float y) { const float z = 0.7978845608028654f * (y + 0.044715f * y * y * y); const float t = 1.0f - 2.0f * rcpf_(1.0f + expf_(2.0f * z)); return 0.5f * y * (1.0f + t); }
#define LDS_WAIT() asm volatile("s_waitcnt lgkmcnt(0)" ::: "memory")
__device__ __forceinline__ float wave_sum(float v) {
#pragma unroll
    for (int o = 1; o < 64; o <<= 1) v += __shfl_xor(v, o);
    return v;
}
__device__ __forceinline__ float wave_max(float v) {
#pragma unroll
    for (int o = 1; o < 64; o <<= 1) v = fmaxf(v, __shfl_xor(v, o));
    return v;
}
__device__ __forceinline__ bf16x8 tr_frag8(LAS const u16* base, int ld, int row0, int col0, int lane) {
    const int fq = lane >> 4, i = lane & 15;
    LAS const u16* a = base + (row0 + fq * 8 + (i >> 2)) * ld + col0 + 4 * (i & 3);
    const s4 lo = __builtin_amdgcn_ds_read_tr16_b64_v4i16((LAS s4*)a);
    const s4 hi = __builtin_amdgcn_ds_read_tr16_b64_v4i16((LAS s4*)(a + 4 * ld));
    return (bf16x8){lo[0], lo[1], lo[2], lo[3], hi[0], hi[1], hi[2], hi[3]};
}
__device__ __forceinline__ s4 tr_frag4(LAS const u16* base, int ld, int row0, int col0, int lane) {
    const int fq = lane >> 4, i = lane & 15;
    LAS const u16* a = base + (row0 + fq * 4 + (i >> 2)) * ld + col0 + 4 * (i & 3);
    return __builtin_amdgcn_ds_read_tr16_b64_v4i16((LAS s4*)a);
}
#define MFMA32(a, b, c) __builtin_amdgcn_mfma_f32_16x16x32_bf16((a), (b), (c), 0, 0, 0)
#define MFMA16(a, b, c) __builtin_amdgcn_mfma_f32_16x16x16bf16_1k((a), (b), (c), 0, 0, 0)

namespace pg8 {
constexpr int BM = 256, BK = 64, HALF = 128, HTB = HALF * BK * 2, STAGE_BYTES = 8 * HTB, NXCD = 8, WGM = 8;
__device__ __forceinline__ int lds_byte(int r, int c) { const int st = (r >> 4) * 2 + (c >> 5), rr = r & 15, cc = c & 31, ob = rr * 64 + cc * 2; return st * 1024 + (ob ^ (((ob >> 9) & 1) << 5)); }
__device__ __forceinline__ void stage_rc(int b, int& R, int& C) { const int st = b / 1024, sb = b % 1024, swz = sb ^ (((sb >> 9) & 1) << 5); R = (st >> 1) * 16 + swz / 64; C = (st & 1) * 32 + (swz % 64) / 2; }
__device__ __forceinline__ int perm32(int rho) { const int n = rho >> 4, i = rho & 15; return 8 * (i >> 2) + 4 * n + (i & 3); }
struct Unit { int pm, pn; };
struct Gemm { const u16* A; const u16* Bt; int M, N, K; };
struct StaticOrder {
    int nM, nN, nwg, G, c;
    __device__ void init(int M, int N, int G_, int c_) { nM = M / BM; nN = N / BM; nwg = nM * nN; G = G_; c = c_; }
    __device__ bool next(int i, Unit& u) const {
        const long L = (long)i * G + c; if (L >= nwg) return false;
        int wgid = (int)L; { const int q = nwg / NXCD, r = nwg % NXCD, xcd = wgid % NXCD, off = wgid / NXCD; wgid = (xcd < r ? xcd * (q + 1) : r * (q + 1) + (xcd - r) * q) + off; }
        const int nig = WGM * nN, gid = wgid / nig, fm = gid * WGM, gsz = (nM - fm) < WGM ? (nM - fm) : WGM;
        u.pm = fm + ((wgid % nig) % gsz); u.pn = (wgid % nig) / gsz; return true;
    }
    __device__ __forceinline__ void a_ready(const Unit&) const {}
    __device__ __forceinline__ void done(const Unit&) const {}
};
template <class Epi, class Sched>
__device__ __forceinline__ void gemm_phase(LAS unsigned char* lds, const Gemm g, const Sched& S, const Epi& E, const int tid) {
    const int wid = __builtin_amdgcn_readfirstlane(tid >> 6), lane = tid & 63, wr = wid >> 2, wc = wid & 3, fr = lane & 15, fq = lane >> 4;
    const int K = g.K, nt = K / BK;
    unsigned voffA[2], voffB[2];
#pragma unroll
    for (int i = 0; i < 2; ++i) { int R, C; stage_rc(tid * 16 + i * 8192, R, C); const int Rb = (R & ~31) + perm32(R & 31);
        voffA[i] = (unsigned)(R * K + C) * 2u; voffB[i] = (unsigned)(Rb * K + C) * 2u; }
    const size_t kstep = (size_t)(BK * 2);
    const size_t hstep = (size_t)HALF * K * 2;
    const size_t tstep = 2 * hstep;
    const unsigned ldsw = (unsigned)wid * 1024u;
    const int aoff = lds_byte(wr * 64 + fr, fq * 8), boff = lds_byte(wc * 32 + fr, fq * 8);
#define PG8_SA(b, h) (((b) * 2 + (h)) * HTB)
#define PG8_SB(b, h) ((4 + (b) * 2 + (h)) * HTB)
#define PG8_STAGE(bufoff, gbase, voff) do { _Pragma("unroll") for (int _i = 0; _i < 2; ++_i) \
        __builtin_amdgcn_global_load_lds((const unsigned*)((const char*)(gbase) + (voff)[_i]), (LAS unsigned*)(lds + (bufoff) + ldsw + _i * 8192), 16, 0, 0); } while (0)
#define PG8_LDA(dst, b, h) do { _Pragma("unroll") for (int m = 0; m < 4; ++m) _Pragma("unroll") for (int k = 0; k < 2; ++k) dst[m][k] = *(const LAS bf16x8*)(lds + PG8_SA(b, h) + aoff + m * 2048 + k * 1024); } while (0)
#define PG8_LDB(dst, b, h) do { _Pragma("unroll") for (int n = 0; n < 2; ++n) _Pragma("unroll") for (int k = 0; k < 2; ++k) dst[n][k] = *(const LAS bf16x8*)(lds + PG8_SB(b, h) + boff + n * 2048 + k * 1024); } while (0)
#define PG8_MMA(ai, bj, At, Bt) do { __builtin_amdgcn_s_setprio(1); _Pragma("unroll") for (int m = 0; m < 4; ++m) _Pragma("unroll") for (int n = 0; n < 2; ++n) _Pragma("unroll") for (int k = 0; k < 2; ++k) \
        acc[ai][bj][m][n] = __builtin_amdgcn_mfma_f32_16x16x32_bf16(Bt[n][k], At[m][k], acc[ai][bj][m][n], 0, 0, 0); __builtin_amdgcn_s_setprio(0); } while (0)
#define PG8_WAIT_V(n) asm volatile("s_waitcnt vmcnt(" #n ")" ::: "memory")
#define PG8_WAIT_L(n) asm volatile("s_waitcnt lgkmcnt(" #n ")" ::: "memory")
#define PG8_BAR __builtin_amdgcn_s_barrier()
#define PG8_SCHED __builtin_amdgcn_sched_barrier(0)
    Unit cur, nxt; int ui = 0;
    if (!S.next(0, cur)) return;
    f32x4 acc[2][2][4][2];
#pragma unroll
    for (int a = 0; a < 2; ++a)
#pragma unroll
        for (int b = 0; b < 2; ++b)
#pragma unroll
            for (int m = 0; m < 4; ++m)
#pragma unroll
                for (int n = 0; n < 2; ++n) acc[a][b][m][n] = (f32x4){0.f, 0.f, 0.f, 0.f};
    bf16x8 At[4][2], B0[2][2], B1[2][2];
    const char* cA = (const char*)g.A + (size_t)cur.pm * tstep; const char* cB = (const char*)g.Bt + (size_t)cur.pn * tstep;
    S.a_ready(cur);
    PG8_STAGE(PG8_SB(0, 0), cB, voffB); PG8_STAGE(PG8_SA(0, 0), cA, voffA); PG8_STAGE(PG8_SB(0, 1), cB + hstep, voffB); PG8_STAGE(PG8_SA(0, 1), cA + hstep, voffA);
    if (wr == 1) PG8_BAR;
    PG8_WAIT_V(4); PG8_BAR;
    PG8_STAGE(PG8_SB(1, 0), cB + kstep, voffB); PG8_STAGE(PG8_SA(1, 0), cA + kstep, voffA); PG8_STAGE(PG8_SB(1, 1), cB + hstep + kstep, voffB);
    PG8_WAIT_V(6); PG8_BAR;
    for (;;) {
        const bool has_next = S.next(ui + 1, nxt);
        const char* nA = has_next ? (const char*)g.A + (size_t)nxt.pm * tstep : cA; const char* nB = has_next ? (const char*)g.Bt + (size_t)nxt.pn * tstep : cB;
        const bool full = cur.pm != (MPAD / 256 - 1);
        for (int t = 0; t < nt; t += 2) {
            const bool last = (t == nt - 2);
            const char* a1 = cA + (size_t)(t + 1) * kstep;
            const char* a2 = last ? nA : cA + (size_t)(t + 2) * kstep; const char* b2 = last ? nB : cB + (size_t)(t + 2) * kstep;
            const char* a3 = a2 + kstep; const char* b3 = b2 + kstep;
            if (last && has_next) S.a_ready(nxt);
            PG8_LDB(B0, 0, 0); PG8_SCHED; PG8_LDA(At, 0, 0); PG8_STAGE(PG8_SA(1, 1), a1 + hstep, voffA);
            PG8_WAIT_L(8); PG8_BAR; PG8_WAIT_L(0); PG8_MMA(0, 0, At, B0); PG8_BAR; PG8_SCHED;
            PG8_LDB(B1, 0, 1); PG8_STAGE(PG8_SB(0, 0), b2, voffB);
            PG8_BAR; PG8_WAIT_L(0); PG8_MMA(0, 1, At, B1); PG8_BAR;
            PG8_LDA(At, 0, 1); PG8_STAGE(PG8_SA(0, 0), a2, voffA);
            PG8_BAR; PG8_WAIT_L(0); if (full) PG8_MMA(1, 0, At, B0); PG8_BAR; PG8_SCHED;
            PG8_STAGE(PG8_SB(0, 1), b2 + hstep, voffB);
            PG8_WAIT_V(6); PG8_BAR; if (full) PG8_MMA(1, 1, At, B1); PG8_BAR;
            PG8_LDB(B0, 1, 0); PG8_SCHED; PG8_LDA(At, 1, 0); PG8_STAGE(PG8_SA(0, 1), a2 + hstep, voffA);
            PG8_WAIT_L(8); PG8_BAR; PG8_WAIT_L(0); PG8_MMA(0, 0, At, B0); PG8_BAR; PG8_SCHED;
            PG8_LDB(B1, 1, 1); PG8_STAGE(PG8_SB(1, 0), b3, voffB);
            PG8_BAR; PG8_WAIT_L(0); PG8_MMA(0, 1, At, B1); PG8_BAR;
            PG8_LDA(At, 1, 1); PG8_STAGE(PG8_SA(1, 0), a3, voffA);
            PG8_BAR; PG8_WAIT_L(0); if (full) PG8_MMA(1, 0, At, B0); PG8_BAR; PG8_SCHED;
            PG8_STAGE(PG8_SB(1, 1), b3 + hstep, voffB);
            PG8_WAIT_V(6); PG8_BAR; if (full) PG8_MMA(1, 1, At, B1); PG8_BAR;
        }
        E(acc, cur, wr, wc, fr, fq); S.done(cur);
        if (!has_next) break;
#pragma unroll
        for (int a = 0; a < 2; ++a)
#pragma unroll
            for (int b = 0; b < 2; ++b)
#pragma unroll
                for (int m = 0; m < 4; ++m)
#pragma unroll
                    for (int n = 0; n < 2; ++n) acc[a][b][m][n] = (f32x4){0.f, 0.f, 0.f, 0.f};
        cur = nxt; cA = nA; cB = nB; ++ui;
    }
    PG8_WAIT_V(0);
    if (wr == 0) PG8_BAR;
    PG8_BAR;
#undef PG8_SA
#undef PG8_SB
#undef PG8_STAGE
#undef PG8_LDA
#undef PG8_LDB
#undef PG8_MMA
#undef PG8_WAIT_V
#undef PG8_WAIT_L
#undef PG8_BAR
#undef PG8_SCHED
}
}
using pg8::Unit;
typedef f32x4 Acc[2][2][4][2];

#define EPI_LOOP_BEGIN \
    _Pragma("unroll") for (int ai = 0; ai < 2; ++ai) if (ai == 0 || u.pm != (MPAD / 256 - 1)) _Pragma("unroll") for (int m = 0; m < 4; ++m) { const int row = u.pm * 256 + ai * 128 + wr * 64 + m * 16 + fr; \
    _Pragma("unroll") for (int bj = 0; bj < 2; ++bj) { const f32x4 v0 = acc[ai][bj][m][0], v1 = acc[ai][bj][m][1]; const int cb = bj * 128 + wc * 32 + 8 * fq;
#define EPI_LOOP_END } }
#define EPI_LOOP_BEGIN_RS(SSQP) \
    float rsA_[2]; { const int l_ = (fq << 4) | fr; _Pragma("unroll") for (int ai = 0; ai < 2; ++ai) { \
        const f32x4* sp_ = (const f32x4*)((SSQP) + (size_t)(u.pm * 256 + ai * 128 + wr * 64 + l_) * 16); const f32x4 a_ = sp_[0], b_ = sp_[1], c_ = sp_[2], d_ = sp_[3]; \
        const float t_ = (((a_[0] + a_[1]) + (a_[2] + a_[3])) + ((b_[0] + b_[1]) + (b_[2] + b_[3]))) + (((c_[0] + c_[1]) + (c_[2] + c_[3])) + ((d_[0] + d_[1]) + (d_[2] + d_[3]))); \
        rsA_[ai] = rsqrtf(t_ * (1.0f / 1024.0f) + 1e-6f); } } \
    _Pragma("unroll") for (int ai = 0; ai < 2; ++ai) if (ai == 0 || u.pm != (MPAD / 256 - 1)) _Pragma("unroll") for (int m = 0; m < 4; ++m) { const int row = u.pm * 256 + ai * 128 + wr * 64 + m * 16 + fr; \
    const float rs_ = __shfl(rsA_[ai], 16 * m + fr); \
    _Pragma("unroll") for (int bj = 0; bj < 2; ++bj) { const f32x4 v0 = acc[ai][bj][m][0] * rs_, v1 = acc[ai][bj][m][1] * rs_; const int cb = bj * 128 + wc * 32 + 8 * fq;

__device__ __forceinline__ u32x4 pack8(f32x4 a, f32x4 b) { u32x4 w; w.x = cvt_pk_bf16(a[0], a[1]); w.y = cvt_pk_bf16(a[2], a[3]); w.z = cvt_pk_bf16(b[0], b[1]); w.w = cvt_pk_bf16(b[2], b[3]); return w; }

template <bool FUSE, bool FIRST>
struct EpiResidT {
    float* X; u16* H; const float* wn; float* SSQ; const float* xin_p; const float* xin_s;
    __device__ __forceinline__ void operator()(const Acc& acc, const Unit& u, int wr, int wc, int fr, int fq) const {
#pragma unroll
        for (int ai = 0; ai < 2; ++ai) if (ai == 0 || u.pm != (MPAD / 256 - 1))
#pragma unroll
            for (int m = 0; m < 4; ++m) { const int row = u.pm * 256 + ai * 128 + wr * 64 + m * 16 + fr; float ss = 0.f;
#pragma unroll
                for (int bj = 0; bj < 2; ++bj) { const int col = u.pn * 256 + bj * 128 + wc * 32 + 8 * fq;
                    f32x4 a, b;
                    if (FIRST) { const float* pi = row < MP ? xin_p + (size_t)row * D + col : xin_s + (size_t)(row - MP) * D + col; a = *(const f32x4*)pi; b = *(const f32x4*)(pi + 4); }
                    else { const u32x4 hx = *(const u32x4*)(H + (size_t)row * D + col);
                        a = (f32x4){bflo(hx.x), bfhi(hx.x), bflo(hx.y), bfhi(hx.y)}; b = (f32x4){bflo(hx.z), bfhi(hx.z), bflo(hx.w), bfhi(hx.w)}; }
                    a += acc[ai][bj][m][0]; b += acc[ai][bj][m][1];
                    if (FUSE) {
                        ss += ((a[0] * a[0] + a[1] * a[1]) + (a[2] * a[2] + a[3] * a[3])) + ((b[0] * b[0] + b[1] * b[1]) + (b[2] * b[2] + b[3] * b[3]));
                        *(u32x4*)(H + (size_t)row * D + col) = pack8(a, b);
                    } else { float* px = X + (size_t)row * D + col; *(f32x4*)px = a; *(f32x4*)(px + 4) = b; } }
                if (FUSE) { ss += __shfl_xor(ss, 16); ss += __shfl_xor(ss, 32); if (fq == 0) SSQ[(size_t)row * 16 + u.pn * 4 + wc] = ss; } }
    }
};
struct EpiHgrnIn {
    u16 *Q, *KK, *V, *GT; float* G; const float* lb; const float* SSQ;
    __device__ __forceinline__ void operator()(const Acc& acc, const Unit& u, int wr, int wc, int fr, int fq) const {
        const int cl = u.pn * 64 + wc * 16 + 4 * fq;
        const f32x4 l4 = *(const f32x4*)(lb + cl);
        EPI_LOOP_BEGIN_RS(SSQ)
            (void)cb;
            const size_t o = (size_t)row * D + cl;
            if (bj == 0) {
                u32x2 wq; wq.x = cvt_pk_bf16(siluf_(v0[0]), siluf_(v0[1])); wq.y = cvt_pk_bf16(siluf_(v0[2]), siluf_(v0[3]));
                *(u32x2*)(Q + o) = wq;
                f32x4 ga;
#pragma unroll
                for (int j = 0; j < 4; ++j) { const float z = v1[j], l = l4[j]; const float e = expf_(-fabsf(z)); const float ls = fminf(z, 0.f) - logf_(1.0f + e); const float emz = z >= 0.f ? e : fminf(rcpf_(e), 1.1420073898156842e26f);
                    ga[j] = ls + logf_(1.0f + l * emz); }
                *(f32x4*)(G + o) = ga;
            } else {
                u32x2 wv; wv.x = cvt_pk_bf16(v0[0], v0[1]); wv.y = cvt_pk_bf16(v0[2], v0[3]);
                *(u32x2*)(V + o) = wv;
                u32x2 wg; wg.x = cvt_pk_bf16(siluf_(v1[0]), siluf_(v1[1])); wg.y = cvt_pk_bf16(siluf_(v1[2]), siluf_(v1[3]));
                *(u32x2*)(GT + o) = wg;
            }
        EPI_LOOP_END
    }
};
struct EpiAttnIn {
    u16 *Qg, *Kg, *Vg, *GT; const f32x2* rcs; float* out; const float* SSQ;
    __device__ __forceinline__ void operator()(const Acc& acc, const Unit& u, int wr, int wc, int fr, int fq) const {
        const int seg = u.pn >> 2;
        if (seg == 9) {
            EPI_LOOP_BEGIN_RS(SSQ)
                *(u32x4*)(GT + (size_t)row * D + (u.pn & 3) * 256 + cb) = pack8(v0, v1);
            EPI_LOOP_END
            return;
        }
        const int g = seg / 3, m3 = seg - 3 * g;
        const int W = g == 0 ? 128 : (g == 1 ? 512 : 2048);
        const size_t outP = g == 0 ? OUT_KV128P : (g == 1 ? OUT_KV512P : OUT_KV2048P);
        const size_t outS = g == 0 ? OUT_KV128S : (g == 1 ? OUT_KV512S : OUT_KV2048S);
        EPI_LOOP_BEGIN_RS(SSQ)
            const int head = (u.pn & 3) * 2 + bj;
            float* dst = nullptr;
            int pidx;
            if (row < MP) { const int b = row >> 11, pos = row & 2047; pidx = pos;
                if (pos >= SEQ - W) dst = out + outP + ((size_t)(b * W + (pos - (SEQ - W))) * 2) * 1024; }
            else { const int rs = row - MP; const int b = rs >> 2, t = rs & 3; pidx = 2048 + t;
                if (row < MALL) dst = out + outS + ((size_t)(b * W + (W - 4 + t)) * 2) * 1024; }
            if (m3 == 2) {
                *(u32x4*)(Vg + (size_t)g * MPAD * D + (size_t)row * D + head * 128 + wc * 32 + 8 * fq) = pack8(v0, v1);
                if (dst) { float* p = dst + 1024 + head * 128 + wc * 32 + 8 * fq; *(f32x4*)p = v0; *(f32x4*)(p + 4) = v1; }
            } else {
                const int i0 = wc * 16 + 4 * fq;
                const f32x2* cs = rcs + (size_t)pidx * 64 + i0;
                const f32x4 cs01 = *(const f32x4*)cs, cs23 = *(const f32x4*)(cs + 2);
                f32x4 o1, o2;
                o1[0] = v0[0] * cs01[0] - v0[1] * cs01[1]; o2[0] = v0[1] * cs01[0] + v0[0] * cs01[1];
                o1[1] = v0[2] * cs01[2] - v0[3] * cs01[3]; o2[1] = v0[3] * cs01[2] + v0[2] * cs01[3];
                o1[2] = v1[0] * cs23[0] - v1[1] * cs23[1]; o2[2] = v1[1] * cs23[0] + v1[0] * cs23[1];
                o1[3] = v1[2] * cs23[2] - v1[3] * cs23[3]; o2[3] = v1[3] * cs23[2] + v1[2] * cs23[3];
                if (m3 == 0) {
                    const float sc = 0.08838834764831845f;
                    u16* q = Qg + (size_t)g * MPAD * D + (size_t)row * D + head * 128 + i0;
                    u32x2 w1, w2; w1.x = cvt_pk_bf16(o1[0] * sc, o1[1] * sc); w1.y = cvt_pk_bf16(o1[2] * sc, o1[3] * sc); w2.x = cvt_pk_bf16(o2[0] * sc, o2[1] * sc); w2.y = cvt_pk_bf16(o2[2] * sc, o2[3] * sc);
                    *(u32x2*)q = w1; *(u32x2*)(q + 64) = w2;
                } else {
                    u16* k = Kg + (size_t)g * MPAD * D + (size_t)row * D + head * 128 + i0;
                    u32x2 w1, w2; w1.x = cvt_pk_bf16(o1[0], o1[1]); w1.y = cvt_pk_bf16(o1[2], o1[3]); w2.x = cvt_pk_bf16(o2[0], o2[1]); w2.y = cvt_pk_bf16(o2[2], o2[3]);
                    *(u32x2*)k = w1; *(u32x2*)(k + 64) = w2;
                    if (dst) { float* p = dst + head * 128 + i0; *(f32x4*)p = o1; *(f32x4*)(p + 64) = o2; }
                }
            }
        EPI_LOOP_END
    }
};
struct EpiS5In {
    u16 *U, *GT; const float* SSQ;
    __device__ __forceinline__ void operator()(const Acc& acc, const Unit& u, int wr, int wc, int fr, int fq) const {
        const int seg = u.pn >> 2, cs0 = (u.pn & 3) * 256;
        EPI_LOOP_BEGIN_RS(SSQ)
            const size_t o = (size_t)row * D + cs0 + cb;
            if (seg == 0) *(u32x4*)(U + o) = pack8(v0, v1);
            else { f32x4 a, b;
#pragma unroll
                for (int j = 0; j < 4; ++j) { a[j] = siluf_(v0[j]); b[j] = siluf_(v1[j]); }
                *(u32x4*)(GT + o) = pack8(a, b); }
        EPI_LOOP_END
    }
};
struct EpiGlu {
    const u16 *Y, *GT; const float* bias; u16* O;
    __device__ __forceinline__ void operator()(const Acc& acc, const Unit& u, int wr, int wc, int fr, int fq) const {
        EPI_LOOP_BEGIN
            const int col = u.pn * 256 + cb; const size_t o = (size_t)row * D + col;
            const u32x4 yy = *(const u32x4*)(Y + o), gg = *(const u32x4*)(GT + o);
            const f32x4 b0 = *(const f32x4*)(bias + col), b1 = *(const f32x4*)(bias + col + 4);
            f32x4 a, b;
            a[0] = bflo(yy.x) * sigmoidf_(v0[0] + b0[0]) * bflo(gg.x); a[1] = bfhi(yy.x) * sigmoidf_(v0[1] + b0[1]) * bfhi(gg.x);
            a[2] = bflo(yy.y) * sigmoidf_(v0[2] + b0[2]) * bflo(gg.y); a[3] = bfhi(yy.y) * sigmoidf_(v0[3] + b0[3]) * bfhi(gg.y);
            b[0] = bflo(yy.z) * sigmoidf_(v1[0] + b1[0]) * bflo(gg.z); b[1] = bfhi(yy.z) * sigmoidf_(v1[1] + b1[1]) * bfhi(gg.z);
            b[2] = bflo(yy.w) * sigmoidf_(v1[2] + b1[2]) * bflo(gg.w); b[3] = bfhi(yy.w) * sigmoidf_(v1[3] + b1[3]) * bfhi(gg.w);
            *(u32x4*)(O + o) = pack8(a, b);
        EPI_LOOP_END
    }
};

constexpr int KVROWS0 = 32 * 124, KVROWS1 = 32 * 508, KVROWS2 = 32 * 2044, KVROWS = KVROWS0 + KVROWS1 + KVROWS2, KVSLICE = (KVROWS + 8) / 9;
__device__ __forceinline__ void kv_row_ptrs(const float* c3, const float* c4, const float* c5, float* out, int R, const f32x4*& src, f32x4*& dst) {
    const bool a = R < KVROWS0, bq = R < KVROWS0 + KVROWS1;
    const float* c = a ? c3 : (bq ? c4 : c5);
    const size_t oo = a ? OUT_KV128S : (bq ? OUT_KV512S : OUT_KV2048S);
    const int L = a ? 128 : (bq ? 512 : 2048);
    const int R2 = R - (a ? 0 : (bq ? KVROWS0 : KVROWS0 + KVROWS1));
    const int b = R2 / (L - 4), row = R2 - b * (L - 4);
    src = (const f32x4*)(c + ((size_t)b * L + row + 4) * 2048); dst = (f32x4*)(out + oo + ((size_t)b * L + row) * 2048);
}
__device__ __forceinline__ void kv_copy_slice(const Ctx& p, int k, int N) {
    const int nwg = (MPAD / 256) * (N / 256), rem = nwg % p.nb;
    int ii = p.bid, ni = p.nb;
    if (rem != 0) { if (p.bid < rem) return; ii = p.bid - rem; ni = p.nb - rem; }
    const int lo = k * KVSLICE, hi = (lo + KVSLICE) < KVROWS ? (lo + KVSLICE) : KVROWS;
    const float* c3 = p.in(3); const float* c4 = p.in(4); const float* c5 = p.in(5); float* po = p.out();
    int R = lo + ii;
    for (; R + 3 * ni < hi; R += 4 * ni) {
        const f32x4 *s0, *s1, *s2, *s3; f32x4 *d0, *d1, *d2, *d3;
        kv_row_ptrs(c3, c4, c5, po, R, s0, d0); kv_row_ptrs(c3, c4, c5, po, R + ni, s1, d1); kv_row_ptrs(c3, c4, c5, po, R + 2 * ni, s2, d2); kv_row_ptrs(c3, c4, c5, po, R + 3 * ni, s3, d3);
        const f32x4 a = __builtin_nontemporal_load(s0 + p.tid), b = __builtin_nontemporal_load(s1 + p.tid), c = __builtin_nontemporal_load(s2 + p.tid), e = __builtin_nontemporal_load(s3 + p.tid);
        __builtin_nontemporal_store(a, d0 + p.tid); __builtin_nontemporal_store(b, d1 + p.tid); __builtin_nontemporal_store(c, d2 + p.tid); __builtin_nontemporal_store(e, d3 + p.tid);
    }
    for (; R < hi; R += ni) { const f32x4* s0; f32x4* d0; kv_row_ptrs(c3, c4, c5, po, R, s0, d0); __builtin_nontemporal_store(__builtin_nontemporal_load(s0 + p.tid), d0 + p.tid); }
}
template <class Epi>
__device__ __forceinline__ void run_gemm(const Ctx& p, LAS unsigned char* lds, const u16* A, const u16* Bt, int N, const Epi& E, int kvslice) {
    pg8::Gemm g; g.A = A; g.Bt = Bt; g.M = MPAD; g.N = N; g.K = D;
    pg8::StaticOrder S; S.init(MPAD, N, p.nb, p.bid);
    pg8::gemm_phase<Epi, pg8::StaticOrder>(lds, g, S, E, p.tid);
    kv_copy_slice(p, kvslice, N);
}

__device__ __forceinline__ void sincos_d(double x, double& s, double& c) {
    const double k = rint(x * 0.15915494309189535);
    double r = fma(-k, 6.283185307179586, x); r = fma(-k, 2.4492935982947064e-16, r);
    const double r2 = r * r;
    double ts = r, tc = 1.0; s = r; c = 1.0;
#pragma unroll 1
    for (int i = 1; i <= 14; ++i) { tc = -tc * r2 / (double)((2 * i - 1) * (2 * i)); ts = -ts * r2 / (double)((2 * i) * (2 * i + 1)); c += tc; s += ts; }
}
__device__ __forceinline__ int wt_dst_row(int col, int mode) {
    if (mode == 2) { const int seg = col >> 10, x = col & 1023, y = x & 63; return (x >> 6) * 256 + 128 * (seg >> 1) + 32 * (y >> 4) + 8 * ((y >> 2) & 3) + 4 * (seg & 1) + (y & 3); }
    if (mode == 1 && col < 9216 && ((col >> 10) % 3) != 2) { const int l = col & 127; return (col & ~127) + 2 * (l & 63) + (l >> 6); }
    return col;
}
__device__ __forceinline__ void transpose_item(const float* W, int K, int N, u16* WT, int mode, LAS float* scr, int item, int lane, const float* nw) {
    const int nblk = N / 32, kb = item / nblk, nb = item % nblk, k0 = 64 * kb, n0 = 32 * nb;
    float tv[32];
#pragma unroll
    for (int i = 0; i < 32; ++i) tv[i] = W[(size_t)(k0 + 2 * i + (lane >> 5)) * N + n0 + (lane & 31)];
    if (nw) {
#pragma unroll
        for (int i = 0; i < 32; ++i) tv[i] *= nw[k0 + 2 * i + (lane >> 5)]; }
#pragma unroll
    for (int i = 0; i < 32; ++i) scr[(2 * i + (lane >> 5)) * 33 + (lane & 31)] = tv[i];
    LDS_WAIT();
    const int c = lane & 7;
#pragma unroll
    for (int j = 0; j < 4; ++j) { const int n = (lane >> 3) + 8 * j; const LAS float* s = scr + (8 * c) * 33 + n;
        u32x4 o; o.x = cvt_pk_bf16(s[0 * 33], s[1 * 33]); o.y = cvt_pk_bf16(s[2 * 33], s[3 * 33]); o.z = cvt_pk_bf16(s[4 * 33], s[5 * 33]); o.w = cvt_pk_bf16(s[6 * 33], s[7 * 33]);
        *(u32x4*)(WT + (size_t)wt_dst_row(n0 + n, mode) * K + k0 + 8 * c) = o; }
    LDS_WAIT();
}
__device__ __forceinline__ void norm_row(const float* xrow, const float* w, u16* hrow, float* xdst, int lane) {
    f32x4 v[4]; float s = 0.f;
#pragma unroll
    for (int j = 0; j < 4; ++j) { v[j] = ((const f32x4*)xrow)[lane + 64 * j]; s += (v[j][0] * v[j][0] + v[j][1] * v[j][1]) + (v[j][2] * v[j][2] + v[j][3] * v[j][3]); }
    const float rstd = rsqrtf(wave_sum(s) * (1.0f / D) + 1e-6f);
#pragma unroll
    for (int j = 0; j < 4; ++j) {
        if (xdst) ((f32x4*)xdst)[lane + 64 * j] = v[j];
        const f32x4 ww = ((const f32x4*)w)[lane + 64 * j];
        u32x2 o; o.x = cvt_pk_bf16(v[j][0] * rstd * ww[0], v[j][1] * rstd * ww[1]); o.y = cvt_pk_bf16(v[j][2] * rstd * ww[2], v[j][3] * rstd * ww[3]);
        ((u32x2*)hrow)[lane + 64 * j] = o;
    }
}
__device__ __forceinline__ void copy_f4(const float* src, float* dst, size_t n4, size_t i0, size_t stride) {
    const f32x4* s = (const f32x4*)src; f32x4* d = (f32x4*)dst;
    size_t i = i0;
    for (; i + 3 * stride < n4; i += 4 * stride) {
        const f32x4 a = __builtin_nontemporal_load(s + i), b = __builtin_nontemporal_load(s + i + stride), c = __builtin_nontemporal_load(s + i + 2 * stride), e = __builtin_nontemporal_load(s + i + 3 * stride);
        __builtin_nontemporal_store(a, d + i); __builtin_nontemporal_store(b, d + i + stride); __builtin_nontemporal_store(c, d + i + 2 * stride); __builtin_nontemporal_store(e, d + i + 3 * stride);
    }
    for (; i < n4; i += stride) __builtin_nontemporal_store(__builtin_nontemporal_load(s + i), d + i);
}
__device__ __forceinline__ void phase_prep(const Ctx& p, LAS unsigned char* lds) {
    const int tid = p.tid, lane = tid & 63, wave = tid >> 6;
    const int gw = p.bid * 8 + wave, NGW = p.nb * 8;
    const size_t gt = (size_t)p.bid * 512 + tid, NGT = (size_t)p.nb * 512;
    unsigned char* ws = p.ws();
#ifndef SKIP_A
    {
        LAS float* scr = (LAS float*)(lds + wave * 16384);
        constexpr int I_AIN = 16 * 128, I_SQ = 16 * 32, I_BIN = 16 * 320, I_CIN = 16 * 64;
        constexpr int NIT = 2 * I_AIN + 2 * I_SQ + I_BIN + I_SQ + I_CIN + I_SQ + I_SQ;
        for (int it = gw; it < NIT; it += NGW) {
            int r = it; const float* W; u16* WT; int N = 1024, mode = 0; const float* nw = nullptr;
            if (r < 2 * I_AIN) { const int l = r / I_AIN; W = p.in(9) + (size_t)l * 1024 * 4096; WT = (u16*)(ws + WS_WT_A_IN) + (size_t)l * 4096 * 1024; N = 4096; mode = 2; nw = p.in(7) + (l ? 3 * D : 0); r = r % I_AIN; }
            else if ((r -= 2 * I_AIN) < 2 * I_SQ) { const int l = r / I_SQ; W = p.in(12) + (size_t)l * 1024 * 1024; WT = (u16*)(ws + WS_WT_A_OUT) + (size_t)l * 1024 * 1024; r = r % I_SQ; }
            else if ((r -= 2 * I_SQ) < I_BIN) { W = p.in(13); WT = (u16*)(ws + WS_WT_B_IN); N = 10240; mode = 1; nw = p.in(7) + D; }
            else if ((r -= I_BIN) < I_SQ) { W = p.in(14); WT = (u16*)(ws + WS_WT_B_OUT); }
            else if ((r -= I_SQ) < I_CIN) { W = p.in(15); WT = (u16*)(ws + WS_WT_C_IN); N = 2048; nw = p.in(7) + 2 * D; }
            else if ((r -= I_CIN) < I_SQ) { W = p.in(24); WT = (u16*)(ws + WS_WT_C_GLU); }
            else { r -= I_SQ; W = p.in(26); WT = (u16*)(ws + WS_WT_C_OUT); }
            transpose_item(W, 1024, N, WT, mode, scr, r, lane, nw);
        }
    }
#endif
#ifndef SKIP_B
    for (int r = gw; r < MPAD; r += NGW) {
        float* xd = (float*)(ws + WS_X) + (size_t)r * D; u16* hd = (u16*)(ws + WS_H) + (size_t)r * D;
        if (r < MALL) { const float* xrow = r < MP ? p.in(0) + (size_t)r * D : p.in(1) + (size_t)(r - MP) * D; const float* w = p.in(7);
            f32x4 v[4]; float sq = 0.f;
#pragma unroll
            for (int j = 0; j < 4; ++j) { v[j] = ((const f32x4*)xrow)[lane + 64 * j]; sq += (v[j][0] * v[j][0] + v[j][1] * v[j][1]) + (v[j][2] * v[j][2] + v[j][3] * v[j][3]); }
            sq = wave_sum(sq);
#pragma unroll
            for (int j = 0; j < 4; ++j) { u32x2 o; o.x = cvt_pk_bf16(v[j][0], v[j][1]); o.y = cvt_pk_bf16(v[j][2], v[j][3]); ((u32x2*)hd)[lane + 64 * j] = o; }
            (void)w;
            if (lane < 16) ((float*)(ws + WS_SSQ))[(size_t)r * 16 + lane] = lane == 0 ? sq : 0.f; }
        else {
#pragma unroll
            for (int j = 0; j < 4; ++j) { ((f32x4*)xd)[lane + 64 * j] = (f32x4){0.f, 0.f, 0.f, 0.f}; ((u32x2*)hd)[lane + 64 * j] = (u32x2){0u, 0u}; }
            u16* od = (u16*)(ws + WS_O) + (size_t)r * D;
#pragma unroll
            for (int j = 0; j < 4; ++j) ((u32x2*)od)[lane + 64 * j] = (u32x2){0u, 0u};
        }
    }
#endif
#ifndef SKIP_C
    for (size_t i = gt; i < (size_t)2052 * 64; i += NGT) {
        const int pi = (int)(i >> 6), fi = (int)(i & 63);
        const double pos = pi < 2048 ? (double)pi : (double)(PAST + pi - 2048);
        double f = 1.0; for (int k = 0; k < fi; ++k) f *= 0.8659643233600653;
        double s, c; sincos_d(pos * f, s, c);
        ((f32x2*)(ws + WS_RCS))[i] = (f32x2){(float)c, (float)s};
    }
    for (size_t i = gt; i < 1024; i += NGT) {
        const float l0 = p.in(10)[i], l1 = p.in(10)[1024 + i];
        ((float*)(ws + WS_LB))[i] = 0.f; ((float*)(ws + WS_LB))[1024 + i] = 1.0f / (1.0f + expf(l0 - l1));
    }
    for (size_t i = gt; i < 4096; i += NGT) {
        const int g = (int)(i >> 6), pp = (int)(i & 63);
        const double lre = fmin((double)p.in(16)[i], -1e-4), lim = (double)p.in(17)[i];
        const double dt = exp((double)p.in(23)[g]);
        const double mag = exp(lre * dt); double sn, cs; sincos_d(lim * dt, sn, cs);
        const double bre = mag * cs, bim = mag * sn;
        ((f32x2*)(ws + WS_LAM))[i] = (f32x2){(float)bre, (float)bim};
        const double den = lre * lre + lim * lim, xr = bre - 1.0;
        const double cre = (xr * lre + bim * lim) / den, cim = (bim * lre - xr * lim) / den;
        u16* SB = (u16*)(ws + WS_SB5); u16* SC = (u16*)(ws + WS_SC5);
        for (int c = 0; c < 16; ++c) {
            const double br = (double)p.in(18)[i * 16 + c], bi = (double)p.in(19)[i * 16 + c];
            const double vre = cre * br - cim * bi, vim = cre * bi + cim * br;
            const float cr = p.in(20)[((size_t)g * 16 + c) * 64 + pp], ci = p.in(21)[((size_t)g * 16 + c) * 64 + pp];
#pragma unroll
            for (int ri = 0; ri < 2; ++ri) {
                const int n = 2 * pp + ri;
                SB[((size_t)(g * 8 + (n >> 4)) * 64 + (c >> 2) * 16 + (n & 15)) * 4 + (c & 3)] = f2bf((float)(ri ? vim : vre));
                SC[((size_t)(g * 4 + (n >> 5)) * 64 + ((n >> 3) & 3) * 16 + c) * 8 + (n & 7)] = f2bf(ri ? -ci : cr);
            }
        }
    }
#endif
}

__device__ __forceinline__ void phase_norm(const Ctx& p, int layer) {
    const int lane = p.tid & 63, gw = p.bid * 8 + (p.tid >> 6), NGW = p.nb * 8;
    for (int r = gw; r < MALL; r += NGW)
        norm_row((const float*)(p.ws() + WS_X) + (size_t)r * D, p.in(7) + (size_t)layer * D, (u16*)(p.ws() + WS_H) + (size_t)r * D, nullptr, lane);
}
__device__ __forceinline__ void phase_final(const Ctx& p) {
    const int lane = p.tid & 63, gw = p.bid * 8 + (p.tid >> 6), NGW = p.nb * 8;
    for (int r = gw; r < MALL; r += NGW) {
        const u16* xrow = (const u16*)(p.ws() + WS_H) + (size_t)r * D;
        float* orow = p.out() + (r < MP ? OUT_YP + (size_t)r * D : OUT_YS + (size_t)(r - MP) * D);
        float ssq = lane < 16 ? ((const float*)(p.ws() + WS_SSQ))[(size_t)r * 16 + lane] : 0.f;
        ssq += __shfl_xor(ssq, 1); ssq += __shfl_xor(ssq, 2); ssq += __shfl_xor(ssq, 4); ssq += __shfl_xor(ssq, 8);
        const float rstd = rsqrtf(__shfl(ssq, 0) * (1.0f / D) + 1e-6f);
#pragma unroll
        for (int j = 0; j < 4; ++j) { const u32x2 xv = ((const u32x2*)xrow)[lane + 64 * j]; const f32x4 ww = ((const f32x4*)p.in(8))[lane + 64 * j];
            ((f32x4*)orow)[lane + 64 * j] = (f32x4){bflo(xv.x) * rstd * ww[0], bfhi(xv.x) * rstd * ww[1], bflo(xv.y) * rstd * ww[2], bfhi(xv.y) * rstd * ww[3]}; }
    }
}

__device__ __forceinline__ void phase_hgrn_local(const Ctx& p, LAS unsigned char* lds) {
    const int tid = p.tid, lane = tid & 63, w = tid >> 6, fr = lane & 15, fq = lane >> 4;
    LAS float* Tot = (LAS float*)lds;
    LAS u16* KhT = (LAS u16*)(lds + 2048);
    LAS u16* Vs = KhT + 128 * 136;
    const float* G = (const float*)(p.ws() + WS_G); const u16* KK = (const u16*)(p.ws() + WS_K); const u16* V = (const u16*)(p.ws() + WS_V);
    float* KVB = (float*)(p.ws() + WS_KVB); float* DEC = (float*)(p.ws() + WS_DEC);
    const int k = tid & 127, tq = tid >> 7;
    for (int task = p.bid; task < 1024; task += p.nb) {
        const int jb = task >> 3, h = task & 7; const size_t row0 = (size_t)jb * 128;
        float bl[32]; float run = 0.f; float kr[32];
#pragma unroll
        for (int i = 0; i < 32; ++i) { const size_t gi = (row0 + tq * 32 + i) * D + h * 128 + k; bl[i] = G[gi]; }
#pragma unroll
        for (int i = 0; i < 32; ++i) { kr[i] = 1.0f - __expf(bl[i]); run += bl[i]; bl[i] = run; }
        Tot[tq * 128 + k] = run;
#pragma unroll
        for (int i = 0; i < 4; ++i) { const int c = tid + 512 * i, r = c >> 4, ch = c & 15;
            *(LAS u32x4*)(Vs + r * 144 + ch * 8) = *(const u32x4*)(V + (row0 + r) * D + h * 128 + ch * 8); }
        __syncthreads();
        float off = 0.f, blast = 0.f;
#pragma unroll
        for (int q = 0; q < 4; ++q) { const float t = Tot[q * 128 + k]; blast += t; if (q < tq) off += t; }
#pragma unroll
        for (int i8 = 0; i8 < 4; ++i8) { float e[8];
#pragma unroll
            for (int i = 0; i < 8; ++i) e[i] = kr[i8 * 8 + i] * __expf(blast - (bl[i8 * 8 + i] + off));
            u32x4 wv; wv.x = cvt_pk_bf16(e[0], e[1]); wv.y = cvt_pk_bf16(e[2], e[3]); wv.z = cvt_pk_bf16(e[4], e[5]); wv.w = cvt_pk_bf16(e[6], e[7]);
            *(LAS u32x4*)(KhT + k * 136 + tq * 32 + i8 * 8) = wv; }
        if (tq == 0) DEC[(size_t)task * 128 + k] = __expf(blast);
        __syncthreads();
        f32x4 acc[8];
#pragma unroll
        for (int nt = 0; nt < 8; ++nt) acc[nt] = (f32x4){0.f, 0.f, 0.f, 0.f};
#pragma unroll
        for (int kk = 0; kk < 4; ++kk) {
            const bf16x8 a = *(const LAS bf16x8*)(KhT + (16 * w + fr) * 136 + 32 * kk + fq * 8);
#pragma unroll
            for (int nt = 0; nt < 8; ++nt) { const bf16x8 b = tr_frag8(Vs, 144, 32 * kk, 16 * nt, lane); acc[nt] = MFMA32(a, b, acc[nt]); }
        }
        float* dst = KVB + (size_t)task * 16384;
#pragma unroll
        for (int nt = 0; nt < 8; ++nt)
#pragma unroll
            for (int j = 0; j < 4; ++j) dst[(16 * w + fq * 4 + j) * 128 + 16 * nt + fr] = acc[nt][j];
        __syncthreads();
    }
}
__device__ __forceinline__ void phase_hgrn_scan(const Ctx& p, int j) {
    const size_t gt = (size_t)p.bid * 512 + p.tid, NGT = (size_t)p.nb * 512;
    const float* KVB = (const float*)(p.ws() + WS_KVB); const float* DEC = (const float*)(p.ws() + WS_DEC); float* SST = (float*)(p.ws() + WS_SST);
    for (size_t it = gt; it < (size_t)64 * 4096; it += NGT) {
        const int seq = (int)(it >> 12), e4 = (int)(it & 4095), b = seq >> 3, h = seq & 7, k = e4 >> 5;
        f32x4 S = (f32x4){0.f, 0.f, 0.f, 0.f};
#pragma unroll 4
        for (int jb = 0; jb < 16; ++jb) {
            const size_t task = (size_t)(b * 16 + jb) * 8 + h;
            *(f32x4*)(SST + task * 16384 + e4 * 4) = S;
            const float d = DEC[task * 128 + k];
            S = S * d + *(const f32x4*)(KVB + task * 16384 + e4 * 4);
        }
        *(f32x4*)(p.out() + OUT_HGP + ((size_t)(j * 8 + b) * 8 + h) * 16384 + e4 * 4) = S;
    }
}
__device__ __forceinline__ void phase_hgrn_out(const Ctx& p, LAS unsigned char* lds, int j) {
    const int tid = p.tid, lane = tid & 63, w = tid >> 6, fr = lane & 15, fq = lane >> 4;
    LAS u16* QtT = (LAS u16*)lds;
    LAS u16* KtT = QtT + 128 * 40;
    LAS u16* KhT = KtT + 128 * 40;
    LAS u16* Vs = KhT + 128 * 40;
    LAS u16* SbT = Vs + 32 * 144;
    LAS u16* Ps = SbT + 128 * 136;
    LAS float* Ob = (LAS float*)(Ps + 32 * 40);
    LAS float* Dec = Ob + 32 * 132;
    LAS float* Tot = Dec + 128;
    const float* G = (const float*)(p.ws() + WS_G); const u16* Q = (const u16*)(p.ws() + WS_Q); const u16* KK = (const u16*)(p.ws() + WS_K); const u16* V = (const u16*)(p.ws() + WS_V);
    const u16* GT = (const u16*)(p.ws() + WS_GT); u16* O = (u16*)(p.ws() + WS_O);
    const float* SST = (const float*)(p.ws() + WS_SST);
    const float* onw = p.in(11) + (size_t)j * 1024;
    const int k = tid & 127, tq = tid >> 7;
    {
        const int ntask = (1024 - p.bid + p.nb - 1) / p.nb, nit = ntask * 4;
        float gC[8]; u16 qC[8]; u32x4 vC, gtC;
#define HG_LOAD(it_, g_, q_, v_, gt_) do { const int tk_ = p.bid + ((it_) >> 2) * p.nb; const size_t r0_ = (size_t)(tk_ >> 3) * 128 + ((it_) & 3) * 32; const int hh_ = tk_ & 7; \
        _Pragma("unroll") for (int i = 0; i < 8; ++i) { const size_t gi_ = (r0_ + tq * 8 + i) * D + hh_ * 128 + k; g_[i] = G[gi_]; q_[i] = Q[gi_]; } \
        { const size_t gi_ = (r0_ + (tid >> 4)) * D + hh_ * 128 + (tid & 15) * 8; v_ = *(const u32x4*)(V + gi_); gt_ = *(const u32x4*)(GT + gi_); } } while (0)
        if (nit > 0) HG_LOAD(0, gC, qC, vC, gtC);
        f32x4 S[8];
#pragma unroll 1
        for (int it = 0; it < nit; ++it) {
            const int task = p.bid + (it >> 2) * p.nb, sc = it & 3, jb = task >> 3, h = task & 7;
            const size_t row0 = (size_t)jb * 128 + sc * 32;
            if (sc == 0) { const float* src = SST + (size_t)task * 16384;
#pragma unroll
                for (int nt = 0; nt < 8; ++nt)
#pragma unroll
                    for (int jj = 0; jj < 4; ++jj) S[nt][jj] = src[(16 * w + fq * 4 + jj) * 128 + 16 * nt + fr]; }
            float bl[8]; float run = 0.f;
#pragma unroll
            for (int i = 0; i < 8; ++i) { run += gC[i]; bl[i] = run; }
            Tot[tq * 128 + k] = run;
            { const int r = tid >> 4, ch = tid & 15; *(LAS u32x4*)(Vs + r * 144 + ch * 8) = vC; }
#pragma unroll
            for (int nt = 0; nt < 8; ++nt) { u32x2 sw; sw.x = cvt_pk_bf16(S[nt][0], S[nt][1]); sw.y = cvt_pk_bf16(S[nt][2], S[nt][3]);
                *(LAS u32x2*)(SbT + (16 * nt + fr) * 136 + 16 * w + fq * 4) = sw; }
            float gN[8]; u16 qN[8]; u32x4 vN, gtN;
            { const int itn = it + 1 < nit ? it + 1 : it; HG_LOAD(itn, gN, qN, vN, gtN); }
            __syncthreads();
            float off = 0.f, blast = 0.f;
#pragma unroll
            for (int q = 0; q < 4; ++q) { const float t = Tot[q * 128 + k]; blast += t; if (q < tq) off += t; }
            { float eq[8], ek[8], eh[8];
#pragma unroll
              for (int i = 0; i < 8; ++i) { const float b = bl[i] + off; const float qq = bf2f(qC[i]), kk = 1.0f - __expf(gC[i]);
                  eq[i] = qq * __expf(b); ek[i] = kk * __expf(fminf(-b, 80.f)); eh[i] = kk * __expf(blast - b); }
              u32x4 wq, wk, wh;
              wq.x = cvt_pk_bf16(eq[0], eq[1]); wq.y = cvt_pk_bf16(eq[2], eq[3]); wq.z = cvt_pk_bf16(eq[4], eq[5]); wq.w = cvt_pk_bf16(eq[6], eq[7]);
              wk.x = cvt_pk_bf16(ek[0], ek[1]); wk.y = cvt_pk_bf16(ek[2], ek[3]); wk.z = cvt_pk_bf16(ek[4], ek[5]); wk.w = cvt_pk_bf16(ek[6], ek[7]);
              wh.x = cvt_pk_bf16(eh[0], eh[1]); wh.y = cvt_pk_bf16(eh[2], eh[3]); wh.z = cvt_pk_bf16(eh[4], eh[5]); wh.w = cvt_pk_bf16(eh[6], eh[7]);
              *(LAS u32x4*)(QtT + k * 40 + tq * 8) = wq; *(LAS u32x4*)(KtT + k * 40 + tq * 8) = wk; *(LAS u32x4*)(KhT + k * 40 + tq * 8) = wh; }
            if (tq == 0) Dec[k] = __expf(blast);
            __syncthreads();
            if (w < 4) {
                const int mt = w >> 1, st = w & 1;
                f32x4 sacc = (f32x4){0.f, 0.f, 0.f, 0.f};
                if (!(mt == 0 && st == 1)) {
#pragma unroll
                    for (int kk = 0; kk < 4; ++kk) {
                        const bf16x8 a = tr_frag8(QtT, 40, 32 * kk, 16 * mt, lane);
                        const bf16x8 b = tr_frag8(KtT, 40, 32 * kk, 16 * st, lane);
                        sacc = MFMA32(a, b, sacc);
                    }
                }
#pragma unroll
                for (int jj = 0; jj < 4; ++jj) { const int t = 16 * mt + fq * 4 + jj, s2 = 16 * st + fr; Ps[t * 40 + s2] = f2bf(s2 <= t ? sacc[jj] : 0.f); }
            }
            __syncthreads();
            { const int mt = w & 1, ntp = w >> 1;
#pragma unroll
              for (int q2 = 0; q2 < 2; ++q2) { const int nt = ntp * 2 + q2;
                  f32x4 oacc = (f32x4){0.f, 0.f, 0.f, 0.f};
                  { const bf16x8 a = *(const LAS bf16x8*)(Ps + (16 * mt + fr) * 40 + fq * 8); const bf16x8 b = tr_frag8(Vs, 144, 0, 16 * nt, lane); oacc = MFMA32(a, b, oacc); }
#pragma unroll
                  for (int kk = 0; kk < 4; ++kk) { const bf16x8 a = tr_frag8(QtT, 40, 32 * kk, 16 * mt, lane); const bf16x8 b = *(const LAS bf16x8*)(SbT + (16 * nt + fr) * 136 + 32 * kk + fq * 8); oacc = MFMA32(a, b, oacc); }
#pragma unroll
                  for (int jj = 0; jj < 4; ++jj) Ob[(16 * mt + fq * 4 + jj) * 132 + 16 * nt + fr] = oacc[jj]; } }
            { float dd[4];
#pragma unroll
              for (int jj = 0; jj < 4; ++jj) dd[jj] = Dec[16 * w + fq * 4 + jj];
              const bf16x8 a = *(const LAS bf16x8*)(KhT + (16 * w + fr) * 40 + fq * 8);
#pragma unroll
              for (int nt = 0; nt < 8; ++nt) { const bf16x8 b = tr_frag8(Vs, 144, 0, 16 * nt, lane); f32x4 c;
#pragma unroll
                  for (int jj = 0; jj < 4; ++jj) c[jj] = S[nt][jj] * dd[jj];
                  S[nt] = MFMA32(a, b, c); } }
            __syncthreads();
            { const int t = tid >> 4, cg8 = tid & 15; const LAS float* orow = Ob + t * 132 + cg8 * 8;
              const f32x4 a = *(const LAS f32x4*)orow, b = *(const LAS f32x4*)(orow + 4);
              float ss = (a[0] * a[0] + a[1] * a[1]) + (a[2] * a[2] + a[3] * a[3]) + (b[0] * b[0] + b[1] * b[1]) + (b[2] * b[2] + b[3] * b[3]);
              ss += __shfl_xor(ss, 1); ss += __shfl_xor(ss, 2); ss += __shfl_xor(ss, 4); ss += __shfl_xor(ss, 8);
              const float rstd = rsqrtf(ss * (1.0f / 128.0f) + 1e-6f);
              const size_t gi = (row0 + t) * D + h * 128 + cg8 * 8;
              const f32x4 w0 = *(const f32x4*)(onw + h * 128 + cg8 * 8), w1 = *(const f32x4*)(onw + h * 128 + cg8 * 8 + 4);
              const u32x4 gg = gtC;
              f32x4 oa, ob;
              oa[0] = a[0] * rstd * w0[0] * bflo(gg.x); oa[1] = a[1] * rstd * w0[1] * bfhi(gg.x); oa[2] = a[2] * rstd * w0[2] * bflo(gg.y); oa[3] = a[3] * rstd * w0[3] * bfhi(gg.y);
              ob[0] = b[0] * rstd * w1[0] * bflo(gg.z); ob[1] = b[1] * rstd * w1[1] * bfhi(gg.z); ob[2] = b[2] * rstd * w1[2] * bflo(gg.w); ob[3] = b[3] * rstd * w1[3] * bfhi(gg.w);
              *(u32x4*)(O + gi) = pack8(oa, ob); }
#pragma unroll
            for (int i = 0; i < 8; ++i) { gC[i] = gN[i]; qC[i] = qN[i]; }
            vC = vN; gtC = gtN;
        }
        __syncthreads();
#undef HG_LOAD
    }
    for (int task = p.bid; task < HG_NS; task += p.nb) {
        {
            const int sb = task >> 3, h = task & 7;
            LAS float* fs = (LAS float*)lds; LAS float* ks = fs + 128; LAS float* qs = ks + 128; LAS float* red = qs + 128;
            LAS float* rs = red + 512;
            const int v = tid & 127, kq = tid >> 7;
            const float* s0 = p.in(2) + ((size_t)(j * 32 + sb) * 8 + h) * 16384;
            float S[32];
#pragma unroll
            for (int i = 0; i < 32; ++i) { S[i] = s0[(kq * 32 + i) * 128 + v]; if ((i & 7) == 7) asm volatile("" ::: "memory"); }
#pragma unroll 1
            for (int t = 0; t < 4; ++t) {
                const size_t row = (size_t)MP + sb * 4 + t; const size_t gi = row * D + h * 128;
                if (tid < 128) { const float f = __expf(G[gi + tid]); fs[tid] = f; ks[tid] = 1.0f - f; qs[tid] = bf2f(Q[gi + tid]); }
                const float vv = bf2f(V[gi + v]);
                __syncthreads();
                float po = 0.f;
#pragma unroll
                for (int i = 0; i < 32; ++i) { const int kk = kq * 32 + i; S[i] = fs[kk] * S[i] + ks[kk] * vv; po += qs[kk] * S[i]; if ((i & 7) == 7) asm volatile("" ::: "memory"); }
                red[kq * 128 + v] = po;
                __syncthreads();
                float o = 0.f;
                if (tid < 128) { o = (red[v] + red[128 + v]) + (red[256 + v] + red[384 + v]); const float ss = wave_sum(o * o); if (lane == 0) rs[w] = ss; }
                __syncthreads();
                if (tid < 128) { const float rstd = rsqrtf((rs[0] + rs[1]) * (1.0f / 128.0f) + 1e-6f);
                    O[gi + v] = f2bf(o * rstd * onw[h * 128 + v] * bf2f(GT[gi + v])); }
                __syncthreads();
            }
            float* d0 = p.out() + OUT_HGS + ((size_t)(j * 32 + sb) * 8 + h) * 16384;
#pragma unroll
            for (int i = 0; i < 32; ++i) { d0[(kq * 32 + i) * 128 + v] = S[i]; if ((i & 7) == 7) asm volatile("" ::: "memory"); }
        }
    }
}

__device__ __forceinline__ void phase_attn(const Ctx& p, LAS unsigned char* lds) {
    const int tid = p.tid, lane = tid & 63, w = tid >> 6, fr = lane & 15, fq = lane >> 4;
    LAS u16* Ks = (LAS u16*)lds;
    LAS u16* Vs = Ks + 256 * 136;
    const u16* Qg = (const u16*)(p.ws() + WS_Q); const u16* Kg = (const u16*)(p.ws() + WS_K); const u16* Vg = (const u16*)(p.ws() + WS_V);
    u16* OG = (u16*)(p.ws() + WS_OG); float* LSE = (float*)(p.ws() + WS_LSE);
    {
        u32x4 kR[8], vR[8]; bf16x8 qN[4];
#define AT_DECODE(task_) const int g_ = (task_) >> 10, rem_ = (task_) & 1023, b_ = rem_ >> 7, h_ = (rem_ >> 4) & 7, q16_ = rem_ & 15; \
        const int d_ = 1 << (2 * g_), nblk_ = 16 >> (2 * g_), r_ = q16_ / nblk_, j_ = q16_ % nblk_;
#define AT_LOAD(task_) do { AT_DECODE(task_) \
        const u16* Kb_ = Kg + (size_t)g_ * MPAD * D + (size_t)b_ * SEQ * D + h_ * 128; const u16* Vb_ = Vg + (size_t)g_ * MPAD * D + (size_t)b_ * SEQ * D + h_ * 128; \
        _Pragma("unroll") for (int i = 0; i < 8; ++i) { const int c = tid + 512 * i, kl = c >> 4, ch = c & 15; const int idx = 128 * (j_ - 1) + kl; \
            kR[i] = (u32x4){0u, 0u, 0u, 0u}; vR[i] = (u32x4){0u, 0u, 0u, 0u}; \
            if (idx >= 0) { const size_t off = (size_t)(idx * d_ + r_) * D + ch * 8; kR[i] = *(const u32x4*)(Kb_ + off); vR[i] = *(const u32x4*)(Vb_ + off); } } \
        const size_t qrow_ = (size_t)b_ * SEQ + (size_t)(128 * j_ + 16 * w + fr) * d_ + r_; \
        _Pragma("unroll") for (int kk = 0; kk < 4; ++kk) qN[kk] = *(const bf16x8*)(Qg + (size_t)g_ * MPAD * D + qrow_ * D + h_ * 128 + kk * 32 + fq * 8); } while (0)
        const int lbid = (p.nb & 7) == 0 ? (p.bid & 7) * (p.nb >> 3) + (p.bid >> 3) : p.bid;
        if (lbid < 3072) AT_LOAD(lbid);
#pragma unroll 1
        for (int task = lbid; task < 3072; task += p.nb) {
            AT_DECODE(task)
            const int g = g_, b = b_, h = h_, d = d_, r = r_, j = j_;
#pragma unroll
            for (int i = 0; i < 8; ++i) { const int c = tid + 512 * i, kl = c >> 4, ch = c & 15;
                *(LAS u32x4*)(Ks + kl * 136 + ch * 8) = kR[i]; *(LAS u32x4*)(Vs + kl * 144 + ch * 8) = vR[i]; }
            bf16x8 qf[4];
#pragma unroll
            for (int kk = 0; kk < 4; ++kk) qf[kk] = qN[kk];
            const size_t qrow = (size_t)b * SEQ + (size_t)(128 * j + 16 * w + fr) * d + r;
            __syncthreads();
            if (task + p.nb < 3072) AT_LOAD(task + p.nb);
            f32x4 st[9]; float mx = -1e30f;
#pragma unroll
            for (int kt = 0; kt < 9; ++kt) {
                f32x4 a = (f32x4){0.f, 0.f, 0.f, 0.f};
#pragma unroll
                for (int kk = 0; kk < 4; ++kk) { const bf16x8 kf = *(const LAS bf16x8*)(Ks + (16 * (w + kt) + fr) * 136 + kk * 32 + fq * 8); a = MFMA32(kf, qf[kk], a); }
#pragma unroll
                for (int jj = 0; jj < 4; ++jj) { const int rel = 128 + fr - 16 * kt - fq * 4 - jj; const int kl = 16 * (w + kt) + fq * 4 + jj;
                    const bool ok = rel >= 0 && rel <= 128 && (j > 0 || kl >= 128);
                    a[jj] = ok ? a[jj] : -1e30f; mx = fmaxf(mx, a[jj]); }
                st[kt] = a;
            }
            mx = fmaxf(mx, __shfl_xor(mx, 16)); mx = fmaxf(mx, __shfl_xor(mx, 32));
            float ls = 0.f;
#pragma unroll
            for (int kt = 0; kt < 9; ++kt)
#pragma unroll
                for (int jj = 0; jj < 4; ++jj) { const float e = __expf(st[kt][jj] - mx); st[kt][jj] = e; ls += e; }
            ls += __shfl_xor(ls, 16); ls += __shfl_xor(ls, 32);
            f32x4 oacc[8];
#pragma unroll
            for (int dt = 0; dt < 8; ++dt) oacc[dt] = (f32x4){0.f, 0.f, 0.f, 0.f};
#pragma unroll
            for (int kt = 0; kt < 8; kt += 2) {
                u32x4 pw; pw.x = cvt_pk_bf16(st[kt][0], st[kt][1]); pw.y = cvt_pk_bf16(st[kt][2], st[kt][3]); pw.z = cvt_pk_bf16(st[kt + 1][0], st[kt + 1][1]); pw.w = cvt_pk_bf16(st[kt + 1][2], st[kt + 1][3]);
                const bf16x8 pb = __builtin_bit_cast(bf16x8, pw);
#pragma unroll
                for (int dt = 0; dt < 8; ++dt) { const s4 v0 = tr_frag4(Vs, 144, 16 * (w + kt), 16 * dt, lane), v1 = tr_frag4(Vs, 144, 16 * (w + kt + 1), 16 * dt, lane);
                    const bf16x8 vf = (bf16x8){v0[0], v0[1], v0[2], v0[3], v1[0], v1[1], v1[2], v1[3]}; oacc[dt] = MFMA32(vf, pb, oacc[dt]); }
            }
            { u32x2 pw; pw.x = cvt_pk_bf16(st[8][0], st[8][1]); pw.y = cvt_pk_bf16(st[8][2], st[8][3]);
              const s4 pb = __builtin_bit_cast(s4, pw);
#pragma unroll
              for (int dt = 0; dt < 8; ++dt) { const s4 vf = tr_frag4(Vs, 144, 16 * (w + 8), 16 * dt, lane); oacc[dt] = MFMA16(vf, pb, oacc[dt]); } }
            const float inv = 1.0f / ls;
            u16* od = OG + (size_t)g * MPAD * D + qrow * D + h * 128;
#pragma unroll
            for (int dt = 0; dt < 8; ++dt) { u32x2 o; o.x = cvt_pk_bf16(oacc[dt][0] * inv, oacc[dt][1] * inv); o.y = cvt_pk_bf16(oacc[dt][2] * inv, oacc[dt][3] * inv);
                *(u32x2*)(od + 16 * dt + fq * 4) = o; }
            if (fq == 0) LSE[((size_t)g * MP + qrow) * 8 + h] = mx + __logf(ls);
            __syncthreads();
        }
#undef AT_LOAD
#undef AT_DECODE
    }
}
__device__ __forceinline__ void phase_merge(const Ctx& p, LAS unsigned char* lds) {
    const int tid = p.tid, lane = tid & 63, w = tid >> 6;
    const u16* Qg = (const u16*)(p.ws() + WS_Q); const u16* Kg = (const u16*)(p.ws() + WS_K); const u16* Vg = (const u16*)(p.ws() + WS_V);
    (void)Kg; (void)Vg;
    {
        LAS float* sc = (LAS float*)lds + w * 400;
        const int gw = w * p.nb + p.bid, NGW = p.nb * 8;
        const int sub = lane & 15, ksl = lane >> 4;
        for (int task = gw; task < 1024; task += NGW) {
            const int b = task >> 5, t = (task >> 3) & 3, h = task & 7;
            const size_t row = (size_t)MP + b * 4 + t;
            float og[3][8], lse[3];
#pragma unroll
            for (int g = 0; g < 3; ++g) {
                const int L = g == 0 ? 128 : (g == 1 ? 512 : 2048), d = g == 0 ? 1 : (g == 1 ? 4 : 16);
                const size_t outS = g == 0 ? OUT_KV128S : (g == 1 ? OUT_KV512S : OUT_KV2048S);
                const float* cache = p.in(3 + g) + (size_t)b * L * 2048 + h * 128 + sub * 8;
                const float* newr = p.out() + outS + ((size_t)b * L - 4) * 2048 + h * 128 + sub * 8;
                float q[8];
                { const u32x4 qq = *(const u32x4*)(Qg + (size_t)g * MPAD * D + row * D + h * 128 + sub * 8);
                  q[0] = bflo(qq.x); q[1] = bfhi(qq.x); q[2] = bflo(qq.y); q[3] = bfhi(qq.y); q[4] = bflo(qq.z); q[5] = bfhi(qq.z); q[6] = bflo(qq.w); q[7] = bfhi(qq.w); }
                LAS float* scg = sc + g * 132;
#pragma unroll 1
                for (int rb = 0; rb < 3; ++rb) {
                    f32x4 ka[12], kc[12];
#pragma unroll
                    for (int u = 0; u < 12; ++u) { int r = (rb * 12 + u) * 4 + ksl; r = r > 128 ? 128 : r; const int idx = L + t - d * r;
                        const float* kp = (idx >= L ? newr : cache) + (size_t)idx * 2048; ka[u] = *(const f32x4*)kp; kc[u] = *(const f32x4*)(kp + 4); }
#pragma unroll
                    for (int u = 0; u < 12; ++u) { const int r = (rb * 12 + u) * 4 + ksl;
                        float sv = (q[0] * ka[u][0] + q[1] * ka[u][1]) + (q[2] * ka[u][2] + q[3] * ka[u][3]) + (q[4] * kc[u][0] + q[5] * kc[u][1]) + (q[6] * kc[u][2] + q[7] * kc[u][3]);
                        sv += __shfl_xor(sv, 1); sv += __shfl_xor(sv, 2); sv += __shfl_xor(sv, 4); sv += __shfl_xor(sv, 8);
                        if (sub == 0 && r < 132) scg[r] = (r <= 128) ? sv : -1e30f; }
                }
                LDS_WAIT();
                float mx = fmaxf(fmaxf(scg[lane], scg[64 + lane]), lane < 4 ? scg[128 + lane] : -1e30f);
                mx = wave_max(mx);
                float e0 = __expf(scg[lane] - mx), e1 = __expf(scg[64 + lane] - mx), e2 = lane < 4 ? __expf(scg[128 + lane] - mx) : 0.f;
                const float lsum = wave_sum(e0 + e1 + e2);
                LDS_WAIT();
                scg[lane] = e0; scg[64 + lane] = e1; if (lane < 4) scg[128 + lane] = e2;
                LDS_WAIT();
                lse[g] = mx + __logf(lsum);
                float o[8];
#pragma unroll
                for (int e = 0; e < 8; ++e) o[e] = 0.f;
#pragma unroll 1
                for (int rb = 0; rb < 3; ++rb) {
                    f32x4 va[12], vc[12];
#pragma unroll
                    for (int u = 0; u < 12; ++u) { int r = (rb * 12 + u) * 4 + ksl; r = r > 128 ? 128 : r; const int idx = L + t - d * r;
                        const float* vp = (idx >= L ? newr : cache) + (size_t)idx * 2048 + 1024; va[u] = *(const f32x4*)vp; vc[u] = *(const f32x4*)(vp + 4); }
#pragma unroll
                    for (int u = 0; u < 12; ++u) { const int r = (rb * 12 + u) * 4 + ksl; const float pr = r < 132 ? scg[r] : 0.f;
#pragma unroll
                        for (int e = 0; e < 4; ++e) { o[e] += pr * va[u][e]; o[4 + e] += pr * vc[u][e]; } }
                }
                const float inv = 1.0f / lsum;
#pragma unroll
                for (int e = 0; e < 8; ++e) { float x = o[e]; x += __shfl_xor(x, 16); x += __shfl_xor(x, 32); og[g][e] = x * inv; }
                LDS_WAIT();
            }
            const float mm = fmaxf(lse[0], fmaxf(lse[1], lse[2]));
            const float w0 = __expf(lse[0] - mm), w1 = __expf(lse[1] - mm), w2 = __expf(lse[2] - mm); const float wi = 1.0f / (w0 + w1 + w2);
            if (ksl == 0) {
                const size_t gi = row * D + h * 128 + sub * 8;
                const u32x4 gg = *(const u32x4*)((const u16*)(p.ws() + WS_GT) + gi);
                float gt[8] = {siluf_(bflo(gg.x)), siluf_(bfhi(gg.x)), siluf_(bflo(gg.y)), siluf_(bfhi(gg.y)), siluf_(bflo(gg.z)), siluf_(bfhi(gg.z)), siluf_(bflo(gg.w)), siluf_(bfhi(gg.w))};
                f32x4 a, c;
#pragma unroll
                for (int e = 0; e < 4; ++e) { a[e] = (w0 * og[0][e] + w1 * og[1][e] + w2 * og[2][e]) * wi * gt[e]; c[e] = (w0 * og[0][4 + e] + w1 * og[1][4 + e] + w2 * og[2][4 + e]) * wi * gt[4 + e]; }
                *(u32x4*)((u16*)(p.ws() + WS_O) + gi) = pack8(a, c);
            }
        }
    }
    const u16* OG = (const u16*)(p.ws() + WS_OG); const float* LSE = (const float*)(p.ws() + WS_LSE); const u16* GT = (const u16*)(p.ws() + WS_GT); u16* O = (u16*)(p.ws() + WS_O);
    const int gpb = (MP * 128 / 64) / p.nb;
    if (w >= 4) {
        const int big = gpb / 4, g0 = (w - 4) * big, g1 = (w == 7) ? gpb : g0 + big;
#pragma unroll 1
        for (int grp = g0; grp < g1; grp += 4) {
            float l0[4], l1[4], l2[4]; u32x4 a[4], b[4], c[4], gg[4]; size_t gi[4];
#pragma unroll
            for (int q = 0; q < 4; ++q) { const int gq = (grp + q < g1) ? grp + q : g1 - 1; const size_t it = ((size_t)p.bid * gpb + gq) * 64 + lane;
                const size_t row = it >> 7; const int c8 = (int)(it & 127), h = c8 >> 4;
                l0[q] = LSE[row * 8 + h]; l1[q] = LSE[((size_t)MP + row) * 8 + h]; l2[q] = LSE[((size_t)2 * MP + row) * 8 + h];
                gi[q] = row * D + c8 * 8;
                a[q] = *(const u32x4*)(OG + gi[q]); b[q] = *(const u32x4*)(OG + (size_t)MPAD * D + gi[q]); c[q] = *(const u32x4*)(OG + (size_t)2 * MPAD * D + gi[q]); gg[q] = *(const u32x4*)(GT + gi[q]); }
#pragma unroll
            for (int q = 0; q < 4; ++q) {
                const float mm = fmaxf(l0[q], fmaxf(l1[q], l2[q])); float w0 = __expf(l0[q] - mm), w1 = __expf(l1[q] - mm), w2 = __expf(l2[q] - mm); const float wi = 1.0f / (w0 + w1 + w2); w0 *= wi; w1 *= wi; w2 *= wi;
                f32x4 x, y;
                x[0] = (w0 * bflo(a[q].x) + w1 * bflo(b[q].x) + w2 * bflo(c[q].x)) * siluf_(bflo(gg[q].x)); x[1] = (w0 * bfhi(a[q].x) + w1 * bfhi(b[q].x) + w2 * bfhi(c[q].x)) * siluf_(bfhi(gg[q].x));
                x[2] = (w0 * bflo(a[q].y) + w1 * bflo(b[q].y) + w2 * bflo(c[q].y)) * siluf_(bflo(gg[q].y)); x[3] = (w0 * bfhi(a[q].y) + w1 * bfhi(b[q].y) + w2 * bfhi(c[q].y)) * siluf_(bfhi(gg[q].y));
                y[0] = (w0 * bflo(a[q].z) + w1 * bflo(b[q].z) + w2 * bflo(c[q].z)) * siluf_(bflo(gg[q].z)); y[1] = (w0 * bfhi(a[q].z) + w1 * bfhi(b[q].z) + w2 * bfhi(c[q].z)) * siluf_(bfhi(gg[q].z));
                y[2] = (w0 * bflo(a[q].w) + w1 * bflo(b[q].w) + w2 * bflo(c[q].w)) * siluf_(bflo(gg[q].w)); y[3] = (w0 * bfhi(a[q].w) + w1 * bfhi(b[q].w) + w2 * bfhi(c[q].w)) * siluf_(bfhi(gg[q].w));
                *(u32x4*)(O + gi[q]) = pack8(x, y);
            }
        }
    }
}

constexpr int S5_NSEG = 4, S5_SEGLEN = SEQ / S5_NSEG;
template <bool FULL>
__device__ __forceinline__ void s5_run(const Ctx& p, LAS float* BU, LAS u16* Xs, int g, size_t row0, int T, float& xr, float& xi, int lane) {
    const int fr = lane & 15, fq = lane >> 4;
    const u16* U = (const u16*)(p.ws() + WS_V); u16* Y = (u16*)(p.ws() + WS_OG);
    s4 bfr[8]; bf16x8 cfr[4];
#pragma unroll
    for (int nt = 0; nt < 8; ++nt) bfr[nt] = *(const s4*)((const u16*)(p.ws() + WS_SB5) + ((size_t)(g * 8 + nt) * 64 + lane) * 4);
    if (FULL) {
#pragma unroll
        for (int kk = 0; kk < 4; ++kk) cfr[kk] = *(const bf16x8*)((const u16*)(p.ws() + WS_SC5) + ((size_t)(g * 4 + kk) * 64 + lane) * 8);
    }
    const f32x2 lam = ((const f32x2*)(p.ws() + WS_LAM))[g * 64 + lane];
    const float dsk = FULL ? p.in(22)[g * 16 + fr] : 0.f;
    s4 ua = *(const s4*)(U + (row0 + fr) * D + g * 16 + fq * 4);
    u16 us[4] = {0, 0, 0, 0};
    if (FULL) {
#pragma unroll
        for (int jj = 0; jj < 4; ++jj) us[jj] = U[(row0 + fq * 4 + jj) * D + g * 16 + fr];
    }
#pragma unroll 1
    for (int t0 = 0; t0 < T; t0 += 16) {
        const int nv = (T - t0) < 16 ? (T - t0) : 16;
        const int tn = (t0 + 16 < T) ? t0 + 16 : t0;
        const s4 ua_n = *(const s4*)(U + (row0 + tn + fr) * D + g * 16 + fq * 4);
        u16 us_n[4] = {0, 0, 0, 0};
        if (FULL) {
#pragma unroll
            for (int jj = 0; jj < 4; ++jj) us_n[jj] = U[(row0 + tn + fq * 4 + jj) * D + g * 16 + fr];
        }
#pragma unroll
        for (int nt = 0; nt < 8; ++nt) { const f32x4 bu = MFMA16(ua, bfr[nt], ((f32x4){0.f, 0.f, 0.f, 0.f}));
#pragma unroll
            for (int jj = 0; jj < 4; ++jj) BU[(fq * 4 + jj) * 132 + 16 * nt + fr] = bu[jj]; }
        LDS_WAIT();
#pragma unroll
        for (int t = 0; t < 16; ++t) {
            if (t < nv) {
                const f32x2 bu = *(const LAS f32x2*)(BU + t * 132 + 2 * lane);
                const float nr = lam[0] * xr - lam[1] * xi + bu[0], ni = lam[0] * xi + lam[1] * xr + bu[1];
                xr = nr; xi = ni;
            }
            if (FULL) *(LAS unsigned*)(Xs + t * 136 + 2 * lane) = cvt_pk_bf16(xr, xi);
        }
        LDS_WAIT();
        if (FULL) {
            f32x4 y = (f32x4){0.f, 0.f, 0.f, 0.f};
#pragma unroll
            for (int kk = 0; kk < 4; ++kk) { const bf16x8 a = *(const LAS bf16x8*)(Xs + fr * 136 + kk * 32 + fq * 8); y = MFMA32(a, cfr[kk], y); }
#pragma unroll
            for (int jj = 0; jj < 4; ++jj) { const int t = fq * 4 + jj;
                if (t < nv) { const size_t gi = (row0 + t0 + t) * D + g * 16 + fr; Y[gi] = f2bf(geluf_(y[jj] + dsk * bf2f(us[jj]))); } }
            LDS_WAIT();
        }
        ua = ua_n;
#pragma unroll
        for (int jj = 0; jj < 4; ++jj) us[jj] = us_n[jj];
    }
}
constexpr size_t WS_S5SEG_BYTES = (size_t)8 * 64 * S5_NSEG * 64 * 8;
__device__ __forceinline__ void phase_s5a(const Ctx& p, LAS unsigned char* lds) {
    const int tid = p.tid, lane = tid & 63, w = tid >> 6;
    LAS float* BU = (LAS float*)(lds + w * 12800); LAS u16* Xs = (LAS u16*)(lds + w * 12800 + 8448);
    f32x2* SEG = (f32x2*)(p.ws() + WS_KVB);
    const int gw = w * p.nb + p.bid, NGW = p.nb * 8;
    constexpr int NPA = 512 * (S5_NSEG - 1);
    for (int task = gw; task < NPA + 2048; task += NGW) {
        if (task < NPA) {
            const int bg = task / (S5_NSEG - 1), seg = task - bg * (S5_NSEG - 1), b = bg >> 6, g = bg & 63;
            float xr = 0.f, xi = 0.f;
            s5_run<false>(p, BU, Xs, g, (size_t)b * SEQ + seg * S5_SEGLEN, S5_SEGLEN, xr, xi, lane);
            SEG[((size_t)bg * S5_NSEG + seg) * 64 + lane] = (f32x2){xr, xi};
        } else {
            const int bg = task - NPA, b = bg >> 6, g = bg & 63;
            const f32x2 s0 = ((const f32x2*)p.in(6))[(size_t)bg * 64 + lane];
            float xr = s0[0], xi = s0[1];
            s5_run<true>(p, BU, Xs, g, (size_t)MP + b * 4, 4, xr, xi, lane);
            *(f32x2*)(p.out() + OUT_S5S + ((size_t)bg * 64 + lane) * 2) = (f32x2){xr, xi};
        }
    }
}
__device__ __forceinline__ void phase_s5c(const Ctx& p, LAS unsigned char* lds) {
    const int tid = p.tid, lane = tid & 63, w = tid >> 6;
    LAS float* BU = (LAS float*)(lds + w * 12800); LAS u16* Xs = (LAS u16*)(lds + w * 12800 + 8448);
    const f32x2* SEG = (const f32x2*)(p.ws() + WS_KVB);
    const int gw = w * p.nb + p.bid, NGW = p.nb * 8;
    for (int task = gw; task < 512 * S5_NSEG; task += NGW) {
        const int bg = task / S5_NSEG, seg = task - bg * S5_NSEG, b = bg >> 6, g = bg & 63;
        const f32x2 lam = ((const f32x2*)(p.ws() + WS_LAM))[g * 64 + lane];
        float pr = lam[0], pi = lam[1];
#pragma unroll
        for (int i = 0; i < 9; ++i) { const float nr = pr * pr - pi * pi, ni = 2.f * pr * pi; pr = nr; pi = ni; }
        float xr = 0.f, xi = 0.f;
        for (int s2 = 0; s2 < seg; ++s2) { const f32x2 e = SEG[((size_t)bg * S5_NSEG + s2) * 64 + lane]; const float nr = pr * xr - pi * xi + e[0], ni = pr * xi + pi * xr + e[1]; xr = nr; xi = ni; }
        s5_run<true>(p, BU, Xs, g, (size_t)b * SEQ + seg * S5_SEGLEN, S5_SEGLEN, xr, xi, lane);
        if (seg == S5_NSEG - 1) *(f32x2*)(p.out() + OUT_S5P + ((size_t)bg * 64 + lane) * 2) = (f32x2){xr, xi};
    }
}

#define XB_TMO      128
#define XB_XCNT(j)  (256  + 64 * (j))
#define XB_XSUB(j)  (1280 + 64 * (j))
#define XB_XGEN(j)  (2304 + 64 * (j))
#define XB_TOP      3328
#define XB_TOPGEN   3392
#define XCD_BAR_WORDS 3456
#define XB_SPIN_CAP (1u << 18)
__device__ __forceinline__ unsigned xb_ld(unsigned* p)              { return __hip_atomic_load(p, __ATOMIC_RELAXED, __HIP_MEMORY_SCOPE_AGENT); }
__device__ __forceinline__ unsigned xb_add(unsigned* p, unsigned v) { return __hip_atomic_fetch_add(p, v, __ATOMIC_RELAXED, __HIP_MEMORY_SCOPE_AGENT); }
__device__ __forceinline__ unsigned xb_xcc_id() { return (unsigned)__builtin_amdgcn_s_getreg((3 << 11) | 20) & 0xFu; }
#define XB_SPIN(cond, bar) do { unsigned _sp = 0; while (cond) { __builtin_amdgcn_s_sleep(1); \
    if ((++_sp & 255u) == 0u) { if (xb_ld(&(bar)[XB_TMO])) break; if (_sp > XB_SPIN_CAP) { atomicAdd(&(bar)[XB_TMO], 1u); break; } } } } while (0)
struct XcdBarrier { unsigned* bar; unsigned x; volatile LAS unsigned* st; };
__device__ __forceinline__ XcdBarrier xcd_barrier_post(unsigned* bar, volatile LAS unsigned* st) {
    XcdBarrier b; b.bar = bar; b.x = xb_xcc_id(); b.st = st;
    if (threadIdx.x == 0) (void)xb_add(&bar[XB_XCNT(b.x)], 1u);
    return b;
}
__device__ __forceinline__ void xcd_barrier_complete(unsigned* bar, unsigned x, unsigned& nloc, unsigned& nx) {
    const unsigned G = gridDim.x * gridDim.y * gridDim.z;
    unsigned sum, cnt, mine, sp = 0u;
    for (;;) {
        sum = 0u; cnt = 0u; mine = 0u;
#pragma unroll
        for (unsigned j = 0; j < 16; ++j) { const unsigned c = xb_ld(&bar[XB_XCNT(j)]); sum += c; cnt += (c > 0u) ? 1u : 0u; mine = (j == x) ? c : mine; }
        if (sum == G) break;
        __builtin_amdgcn_s_sleep(1);
        if ((++sp & 255u) == 0u) { if (xb_ld(&bar[XB_TMO])) break; if (sp > XB_SPIN_CAP) { atomicAdd(&bar[XB_TMO], 1u); break; } }
    }
    nloc = mine > 0u ? mine : 1u; nx = cnt > 0u ? cnt : 1u;
}
__device__ __forceinline__ void xcd_barrier(const XcdBarrier& b) {
    asm volatile("s_waitcnt vmcnt(0)" ::: "memory");
    __syncthreads();
    if (threadIdx.x == 0) {
        unsigned* bar = b.bar;
        __builtin_amdgcn_s_waitcnt(0);
        unsigned nloc = b.st[0], nx = b.st[1];
        if (nloc == 0u) { xcd_barrier_complete(bar, b.x, nloc, nx); b.st[0] = nloc; b.st[1] = nx; }
        const unsigned old = xb_add(&bar[XB_XSUB(b.x)], 1u);
        const unsigned gen = old / nloc;
        if (old + 1u == (gen + 1u) * nloc) {
            __builtin_amdgcn_fence(__ATOMIC_RELEASE, "agent");
            asm volatile("s_waitcnt vmcnt(0)" ::: "memory");
            const unsigned og = xb_add(&bar[XB_TOP], 1u);
            const unsigned tg = og / nx;
            if (og + 1u == (tg + 1u) * nx) xb_add(&bar[XB_TOPGEN], 1u);
            else XB_SPIN(xb_ld(&bar[XB_TOPGEN]) == tg, bar);
            __builtin_amdgcn_fence(__ATOMIC_ACQUIRE, "agent");
            xb_add(&bar[XB_XGEN(b.x)], 1u);
            asm volatile("s_waitcnt vmcnt(0)" ::: "memory");
        } else {
            XB_SPIN(xb_ld(&bar[XB_XGEN(b.x)]) == gen, bar);
            __builtin_amdgcn_fence(__ATOMIC_ACQUIRE, "agent");
            asm volatile("s_waitcnt vmcnt(0)" ::: "memory");
        }
    }
    __syncthreads();
}

__device__ __forceinline__ Ctx launder(LAS unsigned char* lds0, LAS unsigned char*& lds) {
    KargPtr kp = (KargPtr)__builtin_amdgcn_kernarg_segment_ptr();
    int z; asm volatile("s_mov_b32 %0, 0" : "=s"(z), "+s"(kp));
    lds = lds0 + z;
    int t = __builtin_amdgcn_workitem_id_x(), b = __builtin_amdgcn_workgroup_id_x(), n = (int)__builtin_amdgcn_grid_size_x() / 512;
    asm volatile("" : "+v"(t), "+s"(b), "+s"(n));
    Ctx c; c.kp = kp; c.tid = t; c.bid = b; c.nb = n;
    return c;
}
#define PH_BEGIN LAS unsigned char* lds; const Ctx p = launder(lds0, lds); unsigned char* ws = p.ws(); (void)ws; (void)lds;
constexpr int NPHASE = 24;
__global__ void __launch_bounds__(512, 2) mega(Params pp) {
    extern __shared__ __attribute__((aligned(16))) unsigned char shm[];
    LAS unsigned char* lds0 = (LAS unsigned char*)shm;
#if !MK_MULTI
    volatile LAS unsigned* xst = (volatile LAS unsigned*)(shm + LDS_BYTES - 16);
    if (threadIdx.x == 0) { xst[0] = 0u; xst[1] = 0u; }
    __syncthreads();
    const XcdBarrier xb = xcd_barrier_post((unsigned*)(pp.ws + WS_BAR), xst);
#define GRID_BAR(n) do { if ((n) == 0) cg::this_grid().sync(); else xcd_barrier(xb); } while (0)
#else
#define GRID_BAR(n) do { } while (0)
#endif
#if MK_MULTI
    const int ph_lo = pp.ph_lo, ph_hi = pp.ph_hi;
#else
    constexpr int ph_lo = 0, ph_hi = NPHASE;
#endif
#ifndef PH_MASK
#define PH_MASK 0xffffff
#endif
#define EN(n) (((PH_MASK) >> (n)) & 1)
#ifndef DUP_MASK
#define DUP_MASK 0
#endif
#ifndef EXTRA_SYNCS
#define EXTRA_SYNCS 0
#endif
#define DUPN(n) (((DUP_MASK) >> (n)) & 1)
#define PHASE(n, ...) if (EN(n) && ph_lo <= (n) && (n) < ph_hi) { PH_BEGIN __VA_ARGS__ } if (ph_lo <= (n) && (n) + 1 < ph_hi) GRID_BAR(n); \
    if (DUPN(n)) { { PH_BEGIN __VA_ARGS__ } GRID_BAR(1); }
#define HGRN_IN(j, kv) { EpiHgrnIn E; E.Q = (u16*)(ws + WS_Q); E.KK = (u16*)(ws + WS_K); E.V = (u16*)(ws + WS_V); E.GT = (u16*)(ws + WS_GT); E.G = (float*)(ws + WS_G); E.lb = (const float*)(ws + WS_LB) + (j) * 1024; E.SSQ = (const float*)(ws + WS_SSQ); \
        run_gemm(p, lds, (const u16*)(ws + WS_H), (const u16*)(ws + WS_WT_A_IN) + (size_t)(j) * 4096 * 1024, 4096, E, kv); }
#define RESID(wt, kv, fuse, nl, first) { EpiResidT<fuse, first> E; E.xin_p = p.in(0); E.xin_s = p.in(1); E.X = (float*)(ws + WS_X); E.H = (u16*)(ws + WS_H); E.wn = p.in(7) + (nl) * D; E.SSQ = (float*)(ws + WS_SSQ); run_gemm(p, lds, (const u16*)(ws + WS_O), (const u16*)(ws + (wt)), 1024, E, kv); }
#pragma unroll 1
    for (int i = 0; i < EXTRA_SYNCS; ++i) GRID_BAR(1);
    PHASE(0, phase_prep(p, lds);)
    PHASE(1, HGRN_IN(0, 0))
    PHASE(2, phase_hgrn_local(p, lds);)
    PHASE(3, phase_hgrn_scan(p, 0);)
    PHASE(4, phase_hgrn_out(p, lds, 0);)
    PHASE(5, RESID(WS_WT_A_OUT, 1, true, 1, true))
    PHASE(7, { EpiAttnIn E; E.Qg = (u16*)(ws + WS_Q); E.Kg = (u16*)(ws + WS_K); E.Vg = (u16*)(ws + WS_V); E.GT = (u16*)(ws + WS_GT); E.rcs = (const f32x2*)(ws + WS_RCS); E.out = p.out(); E.SSQ = (const float*)(ws + WS_SSQ);
            run_gemm(p, lds, (const u16*)(ws + WS_H), (const u16*)(ws + WS_WT_B_IN), 10240, E, 2); })
    PHASE(8, phase_attn(p, lds);)
    PHASE(9, phase_merge(p, lds);)
    PHASE(10, RESID(WS_WT_B_OUT, 3, true, 2, false))
    PHASE(12, { EpiS5In E; E.U = (u16*)(ws + WS_V); E.GT = (u16*)(ws + WS_GT); E.SSQ = (const float*)(ws + WS_SSQ); run_gemm(p, lds, (const u16*)(ws + WS_H), (const u16*)(ws + WS_WT_C_IN), 2048, E, 4); })
    PHASE(13, phase_s5a(p, lds);)
    PHASE(14, phase_s5c(p, lds);)
    PHASE(15, { EpiGlu E; E.Y = (const u16*)(ws + WS_OG); E.GT = (const u16*)(ws + WS_GT); E.bias = p.in(25); E.O = (u16*)(ws + WS_O);
            run_gemm(p, lds, (const u16*)(ws + WS_OG), (const u16*)(ws + WS_WT_C_GLU), 1024, E, 5); })
    PHASE(16, RESID(WS_WT_C_OUT, 6, true, 3, false))
    PHASE(18, HGRN_IN(1, 7))
    PHASE(19, phase_hgrn_local(p, lds);)
    PHASE(20, phase_hgrn_scan(p, 1);)
    PHASE(21, phase_hgrn_out(p, lds, 1);)
    PHASE(22, RESID(WS_WT_A_OUT + (size_t)1024 * 1024 * 2, 8, true, 0, false))
    PHASE(23, phase_final(p);)
}

extern "C" void kernel_launch(void* const* d_in, const int* in_sizes, int n_in, void* d_out, int out_size, void* d_ws, size_t ws_size, hipStream_t stream) {
    static int grid = 0;
    if (grid == 0) {
        if (n_in != 27 || (size_t)out_size != OUT_END || ws_size < WS_END) { fprintf(stderr, "kernel_launch: unexpected shapes n_in %d out %d ws %zu (need %zu)\n", n_in, out_size, ws_size, (size_t)WS_END); grid = -1; return; }
        int dev = 0, cus = 0, per_cu = 0;
        hipGetDevice(&dev); hipDeviceGetAttribute(&cus, hipDeviceAttributeMultiprocessorCount, dev);
        if (hipFuncSetAttribute((const void*)mega, hipFuncAttributeMaxDynamicSharedMemorySize, LDS_BYTES) != hipSuccess) { fprintf(stderr, "kernel_launch: hipFuncSetAttribute failed\n"); grid = -1; return; }
        if (hipOccupancyMaxActiveBlocksPerMultiprocessor(&per_cu, (const void*)mega, 512, LDS_BYTES) != hipSuccess || per_cu < 1) { fprintf(stderr, "kernel_launch: occupancy query gave %d\n", per_cu); per_cu = 1; }
        (void)hipGetLastError();
        grid = cus * per_cu;
    }
    if (grid < 0) return;
    Params p{};
    for (int i = 0; i < 27; ++i) p.in[i] = (const float*)d_in[i];
    p.out = (float*)d_out; p.ws = (unsigned char*)d_ws;
#if MK_MULTI
    for (int ph = 0; ph < NPHASE; ++ph) { p.ph_lo = ph; p.ph_hi = ph + 1; hipLaunchKernelGGL(mega, dim3(grid), dim3(512), LDS_BYTES, stream, p); }
#else
    p.ph_lo = 0; p.ph_hi = NPHASE;
    (void)hipMemsetAsync((unsigned char*)d_ws + WS_BAR, 0, 16384, stream);
    void* args[] = {&p};
    hipError_t e = hipLaunchCooperativeKernel((const void*)mega, dim3(grid), dim3(512), args, LDS_BYTES, stream);
    if (e != hipSuccess) fprintf(stderr, "cooperative launch failed: %s (grid %d)\n", hipGetErrorString(e), grid);
#endif
}
```

```cpp
#include <hip/hip_runtime.h>
#include <hip/hip_cooperative_groups.h>
#include <cstdio>
namespace cg = cooperative_groups;

#ifndef MK_MULTI
#define MK_MULTI 0
#endif

#ifndef HG_NP
#define HG_NP 1
#endif
#ifndef HG_NS
#define HG_NS 256
#endif
#define LAS __attribute__((address_space(3)))
typedef unsigned short u16;
typedef short bf16x8 __attribute__((ext_vector_type(8)));
typedef short s4 __attribute__((ext_vector_type(4)));
typedef float f32x4 __attribute__((ext_vector_type(4)));
typedef float f32x2 __attribute__((ext_vector_type(2)));
typedef unsigned u32x4 __attribute__((ext_vector_type(4)));
typedef unsigned u32x2 __attribute__((ext_vector_type(2)));

constexpr int D = 1024;
constexpr int MP = 16384;
constexpr int MS = 128;
constexpr int MALL = MP + MS;
constexpr int MPAD = 16640;
constexpr int SEQ = 2048;
constexpr int PAST = 8192;
constexpr int LDS_BYTES = 147456;

constexpr size_t AL(size_t x) { return (x + 255) & ~(size_t)255; }
constexpr size_t ACT_BF = (size_t)MPAD * D * 2;
constexpr size_t ACT_F32 = (size_t)MPAD * D * 4;
constexpr size_t WS_WT_A_IN = 0;
constexpr size_t WS_WT_A_OUT = WS_WT_A_IN + (size_t)2 * 4096 * 1024 * 2;
constexpr size_t WS_WT_B_IN = WS_WT_A_OUT + (size_t)2 * 1024 * 1024 * 2;
constexpr size_t WS_WT_B_OUT = WS_WT_B_IN + (size_t)10240 * 1024 * 2;
constexpr size_t WS_WT_C_IN = WS_WT_B_OUT + (size_t)1024 * 1024 * 2;
constexpr size_t WS_WT_C_GLU = WS_WT_C_IN + (size_t)2048 * 1024 * 2;
constexpr size_t WS_WT_C_OUT = WS_WT_C_GLU + (size_t)1024 * 1024 * 2;
constexpr size_t WS_X = WS_WT_C_OUT + (size_t)1024 * 1024 * 2;
constexpr size_t WS_H = WS_X + ACT_F32;
constexpr size_t WS_O = WS_H + ACT_BF;
constexpr size_t WS_GT = WS_O + ACT_BF;
constexpr size_t WS_Q = WS_GT + ACT_BF;
constexpr size_t WS_K = WS_Q + 3 * ACT_BF;
constexpr size_t WS_V = WS_K + 3 * ACT_BF;
constexpr size_t WS_G = WS_V + 3 * ACT_BF;
constexpr size_t WS_OG = WS_G + ACT_F32;
constexpr size_t WS_LSE = WS_OG + 3 * ACT_BF;
constexpr size_t WS_KVB = WS_LSE + AL((size_t)3 * MP * 8 * 4);
constexpr size_t WS_SST = WS_KVB + (size_t)128 * 8 * 16384 * 4;
constexpr size_t WS_DEC = WS_SST + (size_t)128 * 8 * 16384 * 4;
constexpr size_t WS_RCS = WS_DEC + AL((size_t)128 * 8 * 128 * 4);
constexpr size_t WS_LB = WS_RCS + AL((size_t)2052 * 64 * 8);
constexpr size_t WS_LAM = WS_LB + AL(2 * 1024 * 4);
constexpr size_t WS_SB5 = WS_LAM + AL(64 * 64 * 8);
constexpr size_t WS_SC5 = WS_SB5 + AL(64 * 8 * 64 * 4 * 2);
constexpr size_t WS_SSQ = WS_SC5 + AL(64 * 4 * 64 * 8 * 2);
constexpr size_t WS_BAR = WS_SSQ + AL((size_t)MPAD * 16 * 4);
constexpr size_t WS_END = WS_BAR + 16384;

constexpr size_t OUT_YP = 0;
constexpr size_t OUT_YS = OUT_YP + (size_t)MP * D;
constexpr size_t OUT_HGP = OUT_YS + (size_t)MS * D;
constexpr size_t OUT_HGS = OUT_HGP + (size_t)2 * 8 * 8 * 16384;
constexpr size_t OUT_KV128P = OUT_HGS + (size_t)2 * 32 * 8 * 16384;
constexpr size_t OUT_KV128S = OUT_KV128P + (size_t)8 * 128 * 2048;
constexpr size_t OUT_KV512P = OUT_KV128S + (size_t)32 * 128 * 2048;
constexpr size_t OUT_KV512S = OUT_KV512P + (size_t)8 * 512 * 2048;
constexpr size_t OUT_KV2048P = OUT_KV512S + (size_t)32 * 512 * 2048;
constexpr size_t OUT_KV2048S = OUT_KV2048P + (size_t)8 * 2048 * 2048;
constexpr size_t OUT_S5P = OUT_KV2048S + (size_t)32 * 2048 * 2048;
constexpr size_t OUT_S5S = OUT_S5P + (size_t)8 * 64 * 64 * 2;
constexpr size_t OUT_END = OUT_S5S + (size_t)32 * 64 * 64 * 2;

struct Params {
    const float* in[27];
    float* out;
    unsigned char* ws;
    int ph_lo, ph_hi;
    int tid, bid, nb, pad_;
};

typedef const __attribute__((address_space(4))) Params* KargPtr;
struct Ctx {
    KargPtr kp; int tid, bid, nb;
    __device__ __forceinline__ const float* in(int i) const { return kp->in[i]; }
    __device__ __forceinline__ float* out() const { return kp->out; }
    __device__ __forceinline__ unsigned char* ws() const { return kp->ws; }
};
__device__ __forceinline__ unsigned cvt_pk_bf16(float lo, float hi) { unsigned r; asm volatile("v_cvt_pk_bf16_f32 %0, %1, %2" : "=v"(r) : "v"(lo), "v"(hi)); return r; }
__device__ __forceinline__ u16 f2bf(float f) { return (u16)(cvt_pk_bf16(f, 0.f) & 0xffffu); }
__device__ __forceinline__ float bf2f(u16 b) { return __uint_as_float(((unsigned)b) << 16); }
__device__ __forceinline__ float bflo(unsigned w) { return __uint_as_float(w << 16); }
__device__ __forceinline__ float bfhi(unsigned w) { return __uint_as_float(w & 0xffff0000u); }
__device__ __forceinline__ float rcpf_(float x) { return __builtin_amdgcn_rcpf(x); }
__device__ __forceinline__ float exp2f_(float x) { return __builtin_amdgcn_exp2f(x); }
__device__ __forceinline__ float expf_(float x) { return __builtin_amdgcn_exp2f(x * 1.4426950408889634f); }
__device__ __forceinline__ float logf_(float x) { return __builtin_amdgcn_logf(x) * 0.6931471805599453f; }
__device__ __forceinline__ float sigmoidf_(float x) { return rcpf_(1.0f + expf_(-x)); }
__device__ __forceinline__ float siluf_(float x) { return x * rcpf_(1.0f + expf_(-x)); }
__device__ __forceinline__ float geluf_(float y) { const float z = 0.7978845608028654f * (y + 0.044715f * y * y * y); const float t = 1.0f - 2.0f * rcpf_(1.0f + expf_(2.0f * z)); return 0.5f * y * (1.0f + t); }
#define LDS_WAIT() asm volatile("s_waitcnt lgkmcnt(0)" ::: "memory")
__device__ __forceinline__ float wave_sum(float v) {
#pragma unroll
    for (int o = 1; o < 64; o <<= 1) v += __shfl_xor(v, o);
    return v;
}
__device__ __forceinline__ float wave_max(float v) {
#pragma unroll
    for (int o = 1; o < 64; o <<= 1) v = fmaxf(v, __shfl_xor(v, o));
    return v;
}
__device__ __forceinline__ bf16x8 tr_frag8(LAS const u16* base, int ld, int row0, int col0, int lane) {
    const int fq = lane >> 4, i = lane & 15;
    LAS const u16* a = base + (row0 + fq * 8 + (i >> 2)) * ld + col0 + 4 * (i & 3);
    const s4 lo = __builtin_amdgcn_ds_read_tr16_b64_v4i16((LAS s4*)a);
    const s4 hi = __builtin_amdgcn_ds_read_tr16_b64_v4i16((LAS s4*)(a + 4 * ld));
    return (bf16x8){lo[0], lo[1], lo[2], lo[3], hi[0], hi[1], hi[2], hi[3]};
}
__device__ __forceinline__ s4 tr_frag4(LAS const u16* base, int ld, int row0, int col0, int lane) {
    const int fq = lane >> 4, i = lane & 15;
    LAS const u16* a = base + (row0 + fq * 4 + (i >> 2)) * ld + col0 + 4 * (i & 3);
    return __builtin_amdgcn_ds_read_tr16_b64_v4i16((LAS s4*)a);
}
#define MFMA32(a, b, c) __builtin_amdgcn_mfma_f32_16x16x32_bf16((a), (b), (c), 0, 0, 0)
#define MFMA16(a, b, c) __builtin_amdgcn_mfma_f32_16x16x16bf16_1k((a), (b), (c), 0, 0, 0)

namespace pg8 {
constexpr int BM = 256, BK = 64, HALF = 128, HTB = HALF * BK * 2, STAGE_BYTES = 8 * HTB, NXCD = 8, WGM = 8;
__device__ __forceinline__ int lds_byte(int r, int c) { const int st = (r >> 4) * 2 + (c >> 5), rr = r & 15, cc = c & 31, ob = rr * 64 + cc * 2; return st * 1024 + (ob ^ (((ob >> 9) & 1) << 5)); }
__device__ __forceinline__ void stage_rc(int b, int& R, int& C) { const int st = b / 1024, sb = b % 1024, swz = sb ^ (((sb >> 9) & 1) << 5); R = (st >> 1) * 16 + swz / 64; C = (st & 1) * 32 + (swz % 64) / 2; }
__device__ __forceinline__ int perm32(int rho) { const int n = rho >> 4, i = rho & 15; return 8 * (i >> 2) + 4 * n + (i & 3); }
struct Unit { int pm, pn; };
struct Gemm { const u16* A; const u16* Bt; int M, N, K; };
struct StaticOrder {
    int nM, nN, nwg, G, c;
    __device__ void init(int M, int N, int G_, int c_) { nM = M / BM; nN = N / BM; nwg = nM * nN; G = G_; c = c_; }
    __device__ bool next(int i, Unit& u) const {
        const long L = (long)i * G + c; if (L >= nwg) return false;
        int wgid = (int)L; { const int q = nwg / NXCD, r = nwg % NXCD, xcd = wgid % NXCD, off = wgid / NXCD; wgid = (xcd < r ? xcd * (q + 1) : r * (q + 1) + (xcd - r) * q) + off; }
        const int nig = WGM * nN, gid = wgid / nig, fm = gid * WGM, gsz = (nM - fm) < WGM ? (nM - fm) : WGM;
        u.pm = fm + ((wgid % nig) % gsz); u.pn = (wgid % nig) / gsz; return true;
    }
    __device__ __forceinline__ void a_ready(const Unit&) const {}
    __device__ __forceinline__ void done(const Unit&) const {}
};
template <class Epi, class Sched>
__device__ __forceinline__ void gemm_phase(LAS unsigned char* lds, const Gemm g, const Sched& S, const Epi& E, const int tid) {
    const int wid = __builtin_amdgcn_readfirstlane(tid >> 6), lane = tid & 63, wr = wid >> 2, wc = wid & 3, fr = lane & 15, fq = lane >> 4;
    const int K = g.K, nt = K / BK;
    unsigned voffA[2], voffB[2];
#pragma unroll
    for (int i = 0; i < 2; ++i) { int R, C; stage_rc(tid * 16 + i * 8192, R, C); const int Rb = (R & ~31) + perm32(R & 31);
        voffA[i] = (unsigned)(R * K + C) * 2u; voffB[i] = (unsigned)(Rb * K + C) * 2u; }
    const size_t kstep = (size_t)(BK * 2);
    const size_t hstep = (size_t)HALF * K * 2;
    const size_t tstep = 2 * hstep;
    const unsigned ldsw = (unsigned)wid * 1024u;
    const int aoff = lds_byte(wr * 64 + fr, fq * 8), boff = lds_byte(wc * 32 + fr, fq * 8);
#define PG8_SA(b, h) (((b) * 2 + (h)) * HTB)
#define PG8_SB(b, h) ((4 + (b) * 2 + (h)) * HTB)
#define PG8_STAGE(bufoff, gbase, voff) do { _Pragma("unroll") for (int _i = 0; _i < 2; ++_i) \
        __builtin_amdgcn_global_load_lds((const unsigned*)((const char*)(gbase) + (voff)[_i]), (LAS unsigned*)(lds + (bufoff) + ldsw + _i * 8192), 16, 0, 0); } while (0)
#define PG8_LDA(dst, b, h) do { _Pragma("unroll") for (int m = 0; m < 4; ++m) _Pragma("unroll") for (int k = 0; k < 2; ++k) dst[m][k] = *(const LAS bf16x8*)(lds + PG8_SA(b, h) + aoff + m * 2048 + k * 1024); } while (0)
#define PG8_LDB(dst, b, h) do { _Pragma("unroll") for (int n = 0; n < 2; ++n) _Pragma("unroll") for (int k = 0; k < 2; ++k) dst[n][k] = *(const LAS bf16x8*)(lds + PG8_SB(b, h) + boff + n * 2048 + k * 1024); } while (0)
#define PG8_MMA(ai, bj, At, Bt) do { __builtin_amdgcn_s_setprio(1); _Pragma("unroll") for (int m = 0; m < 4; ++m) _Pragma("unroll") for (int n = 0; n < 2; ++n) _Pragma("unroll") for (int k = 0; k < 2; ++k) \
        acc[ai][bj][m][n] = __builtin_amdgcn_mfma_f32_16x16x32_bf16(Bt[n][k], At[m][k], acc[ai][bj][m][n], 0, 0, 0); __builtin_amdgcn_s_setprio(0); } while (0)
#define PG8_WAIT_V(n) asm volatile("s_waitcnt vmcnt(" #n ")" ::: "memory")
#define PG8_WAIT_L(n) asm volatile("s_waitcnt lgkmcnt(" #n ")" ::: "memory")
#define PG8_BAR __builtin_amdgcn_s_barrier()
#define PG8_SCHED __builtin_amdgcn_sched_barrier(0)
    Unit cur, nxt; int ui = 0;
    if (!S.next(0, cur)) return;
    f32x4 acc[2][2][4][2];
#pragma unroll
    for (int a = 0; a < 2; ++a)
#pragma unroll
        for (int b = 0; b < 2; ++b)
#pragma unroll
            for (int m = 0; m < 4; ++m)
#pragma unroll
                for (int n = 0; n < 2; ++n) acc[a][b][m][n] = (f32x4){0.f, 0.f, 0.f, 0.f};
    bf16x8 At[4][2], B0[2][2], B1[2][2];
    const char* cA = (const char*)g.A + (size_t)cur.pm * tstep; const char* cB = (const char*)g.Bt + (size_t)cur.pn * tstep;
    S.a_ready(cur);
    PG8_STAGE(PG8_SB(0, 0), cB, voffB); PG8_STAGE(PG8_SA(0, 0), cA, voffA); PG8_STAGE(PG8_SB(0, 1), cB + hstep, voffB); PG8_STAGE(PG8_SA(0, 1), cA + hstep, voffA);
    if (wr == 1) PG8_BAR;
    PG8_WAIT_V(4); PG8_BAR;
    PG8_STAGE(PG8_SB(1, 0), cB + kstep, voffB); PG8_STAGE(PG8_SA(1, 0), cA + kstep, voffA); PG8_STAGE(PG8_SB(1, 1), cB + hstep + kstep, voffB);
    PG8_WAIT_V(6); PG8_BAR;
    for (;;) {
        const bool has_next = S.next(ui + 1, nxt);
        const char* nA = has_next ? (const char*)g.A + (size_t)nxt.pm * tstep : cA; const char* nB = has_next ? (const char*)g.Bt + (size_t)nxt.pn * tstep : cB;
        const bool full = cur.pm != (MPAD / 256 - 1);
        for (int t = 0; t < nt; t += 2) {
            const bool last = (t == nt - 2);
            const char* a1 = cA + (size_t)(t + 1) * kstep;
            const char* a2 = last ? nA : cA + (size_t)(t + 2) * kstep; const char* b2 = last ? nB : cB + (size_t)(t + 2) * kstep;
            const char* a3 = a2 + kstep; const char* b3 = b2 + kstep;
            if (last && has_next) S.a_ready(nxt);
            PG8_LDB(B0, 0, 0); PG8_SCHED; PG8_LDA(At, 0, 0); PG8_STAGE(PG8_SA(1, 1), a1 + hstep, voffA);
            PG8_WAIT_L(8); PG8_BAR; PG8_WAIT_L(0); PG8_MMA(0, 0, At, B0); PG8_BAR; PG8_SCHED;
            PG8_LDB(B1, 0, 1); PG8_STAGE(PG8_SB(0, 0), b2, voffB);
            PG8_BAR; PG8_WAIT_L(0); PG8_MMA(0, 1, At, B1); PG8_BAR;
            PG8_LDA(At, 0, 1); PG8_STAGE(PG8_SA(0, 0), a2, voffA);
            PG8_BAR; PG8_WAIT_L(0); if (full) PG8_MMA(1, 0, At, B0); PG8_BAR; PG8_SCHED;
            PG8_STAGE(PG8_SB(0, 1), b2 + hstep, voffB);
            PG8_WAIT_V(6); PG8_BAR; if (full) PG8_MMA(1, 1, At, B1); PG8_BAR;
            PG8_LDB(B0, 1, 0); PG8_SCHED; PG8_LDA(At, 1, 0); PG8_STAGE(PG8_SA(0, 1), a2 + hstep, voffA);
            PG8_WAIT_L(8); PG8_BAR; PG8_WAIT_L(0); PG8_MMA(0, 0, At, B0); PG8_BAR; PG8_SCHED;
            PG8_LDB(B1, 1, 1); PG8_STAGE(PG8_SB(1, 0), b3, voffB);
            PG8_BAR; PG8_WAIT_L(0); PG8_MMA(0, 1, At, B1); PG8_BAR;
            PG8_LDA(At, 1, 1); PG8_STAGE(PG8_SA(1, 0), a3, voffA);
            PG8_BAR; PG8_WAIT_L(0); if (full) PG8_MMA(1, 0, At, B0); PG8_BAR; PG8_SCHED;
            PG8_STAGE(PG8_SB(1, 1), b3 + hstep, voffB);
            PG8_WAIT_V(6); PG8_BAR; if (full) PG8_MMA(1, 1, At, B1); PG8_BAR;
        }
        E(acc, cur, wr, wc, fr, fq); S.done(cur);
        if (!has_next) break;
#pragma unroll
        for (int a = 0; a < 2; ++a)
#pragma unroll
            for (int b = 0; b < 2; ++b)
#pragma unroll
                for (int m = 0; m < 4; ++m)
#pragma unroll
                    for (int n = 0; n < 2; ++n) acc[a][b][m][n] = (f32x4){0.f, 0.f, 0.f, 0.f};
        cur = nxt; cA = nA; cB = nB; ++ui;
    }
    PG8_WAIT_V(0);
    if (wr == 0) PG8_BAR;
    PG8_BAR;
#undef PG8_SA
#undef PG8_SB
#undef PG8_STAGE
#undef PG8_LDA
#undef PG8_LDB
#undef PG8_MMA
#undef PG8_WAIT_V
#undef PG8_WAIT_L
#undef PG8_BAR
#undef PG8_SCHED
}
}
using pg8::Unit;
typedef f32x4 Acc[2][2][4][2];

#define EPI_LOOP_BEGIN \
    _Pragma("unroll") for (int ai = 0; ai < 2; ++ai) if (ai == 0 || u.pm != (MPAD / 256 - 1)) _Pragma("unroll") for (int m = 0; m < 4; ++m) { const int row = u.pm * 256 + ai * 128 + wr * 64 + m * 16 + fr; \
    _Pragma("unroll") for (int bj = 0; bj < 2; ++bj) { const f32x4 v0 = acc[ai][bj][m][0], v1 = acc[ai][bj][m][1]; const int cb = bj * 128 + wc * 32 + 8 * fq;
#define EPI_LOOP_END } }
#define EPI_LOOP_BEGIN_RS(SSQP) \
    float rsA_[2]; { const int l_ = (fq << 4) | fr; _Pragma("unroll") for (int ai = 0; ai < 2; ++ai) { \
        const f32x4* sp_ = (const f32x4*)((SSQP) + (size_t)(u.pm * 256 + ai * 128 + wr * 64 + l_) * 16); const f32x4 a_ = sp_[0], b_ = sp_[1], c_ = sp_[2], d_ = sp_[3]; \
        const float t_ = (((a_[0] + a_[1]) + (a_[2] + a_[3])) + ((b_[0] + b_[1]) + (b_[2] + b_[3]))) + (((c_[0] + c_[1]) + (c_[2] + c_[3])) + ((d_[0] + d_[1]) + (d_[2] + d_[3]))); \
        rsA_[ai] = rsqrtf(t_ * (1.0f / 1024.0f) + 1e-6f); } } \
    _Pragma("unroll") for (int ai = 0; ai < 2; ++ai) if (ai == 0 || u.pm != (MPAD / 256 - 1)) _Pragma("unroll") for (int m = 0; m < 4; ++m) { const int row = u.pm * 256 + ai * 128 + wr * 64 + m * 16 + fr; \
    const float rs_ = __shfl(rsA_[ai], 16 * m + fr); \
    _Pragma("unroll") for (int bj = 0; bj < 2; ++bj) { const f32x4 v0 = acc[ai][bj][m][0] * rs_, v1 = acc[ai][bj][m][1] * rs_; const int cb = bj * 128 + wc * 32 + 8 * fq;

__device__ __forceinline__ u32x4 pack8(f32x4 a, f32x4 b) { u32x4 w; w.x = cvt_pk_bf16(a[0], a[1]); w.y = cvt_pk_bf16(a[2], a[3]); w.z = cvt_pk_bf16(b[0], b[1]); w.w = cvt_pk_bf16(b[2], b[3]); return w; }

template <bool FUSE, bool FIRST>
struct EpiResidT {
    float* X; u16* H; const float* wn; float* SSQ; const float* xin_p; const float* xin_s;
    __device__ __forceinline__ void operator()(const Acc& acc, const Unit& u, int wr, int wc, int fr, int fq) const {
#pragma unroll
        for (int ai = 0; ai < 2; ++ai) if (ai == 0 || u.pm != (MPAD / 256 - 1))
#pragma unroll
            for (int m = 0; m < 4; ++m) { const int row = u.pm * 256 + ai * 128 + wr * 64 + m * 16 + fr; float ss = 0.f;
#pragma unroll
                for (int bj = 0; bj < 2; ++bj) { const int col = u.pn * 256 + bj * 128 + wc * 32 + 8 * fq;
                    f32x4 a, b;
                    if (FIRST) { const float* pi = row < MP ? xin_p + (size_t)row * D + col : xin_s + (size_t)(row - MP) * D + col; a = *(const f32x4*)pi; b = *(const f32x4*)(pi + 4); }
                    else { const u32x4 hx = *(const u32x4*)(H + (size_t)row * D + col);
                        a = (f32x4){bflo(hx.x), bfhi(hx.x), bflo(hx.y), bfhi(hx.y)}; b = (f32x4){bflo(hx.z), bfhi(hx.z), bflo(hx.w), bfhi(hx.w)}; }
                    a += acc[ai][bj][m][0]; b += acc[ai][bj][m][1];
                    if (FUSE) {
                        ss += ((a[0] * a[0] + a[1] * a[1]) + (a[2] * a[2] + a[3] * a[3])) + ((b[0] * b[0] + b[1] * b[1]) + (b[2] * b[2] + b[3] * b[3]));
                        *(u32x4*)(H + (size_t)row * D + col) = pack8(a, b);
                    } else { float* px = X + (size_t)row * D + col; *(f32x4*)px = a; *(f32x4*)(px + 4) = b; } }
                if (FUSE) { ss += __shfl_xor(ss, 16); ss += __shfl_xor(ss, 32); if (fq == 0) SSQ[(size_t)row * 16 + u.pn * 4 + wc] = ss; } }
    }
};
struct EpiHgrnIn {
    u16 *Q, *KK, *V, *GT; float* G; const float* lb; const float* SSQ;
    __device__ __forceinline__ void operator()(const Acc& acc, const Unit& u, int wr, int wc, int fr, int fq) const {
        const int cl = u.pn * 64 + wc * 16 + 4 * fq;
        const f32x4 l4 = *(const f32x4*)(lb + cl);
        EPI_LOOP_BEGIN_RS(SSQ)
            (void)cb;
            const size_t o = (size_t)row * D + cl;
            if (bj == 0) {
                u32x2 wq; wq.x = cvt_pk_bf16(siluf_(v0[0]), siluf_(v0[1])); wq.y = cvt_pk_bf16(siluf_(v0[2]), siluf_(v0[3]));
                *(u32x2*)(Q + o) = wq;
                f32x4 ga;
#pragma unroll
                for (int j = 0; j < 4; ++j) { const float z = v1[j], l = l4[j]; const float e = expf_(-fabsf(z)); const float ls = fminf(z, 0.f) - logf_(1.0f + e); const float emz = z >= 0.f ? e : fminf(rcpf_(e), 1.1420073898156842e26f);
                    ga[j] = ls + logf_(1.0f + l * emz); }
                *(f32x4*)(G + o) = ga;
            } else {
                u32x2 wv; wv.x = cvt_pk_bf16(v0[0], v0[1]); wv.y = cvt_pk_bf16(v0[2], v0[3]);
                *(u32x2*)(V + o) = wv;
                u32x2 wg; wg.x = cvt_pk_bf16(siluf_(v1[0]), siluf_(v1[1])); wg.y = cvt_pk_bf16(siluf_(v1[2]), siluf_(v1[3]));
                *(u32x2*)(GT + o) = wg;
            }
        EPI_LOOP_END
    }
};
struct EpiAttnIn {
    u16 *Qg, *Kg, *Vg, *GT; const f32x2* rcs; float* out; const float* SSQ;
    __device__ __forceinline__ void operator()(const Acc& acc, const Unit& u, int wr, int wc, int fr, int fq) const {
        const int seg = u.pn >> 2;
        if (seg == 9) {
            EPI_LOOP_BEGIN_RS(SSQ)
                *(u32x4*)(GT + (size_t)row * D + (u.pn & 3) * 256 + cb) = pack8(v0, v1);
            EPI_LOOP_END
            return;
        }
        const int g = seg / 3, m3 = seg - 3 * g;
        const int W = g == 0 ? 128 : (g == 1 ? 512 : 2048);
        const size_t outP = g == 0 ? OUT_KV128P : (g == 1 ? OUT_KV512P : OUT_KV2048P);
        const size_t outS = g == 0 ? OUT_KV128S : (g == 1 ? OUT_KV512S : OUT_KV2048S);
        EPI_LOOP_BEGIN_RS(SSQ)
            const int head = (u.pn & 3) * 2 + bj;
            float* dst = nullptr;
            int pidx;
            if (row < MP) { const int b = row >> 11, pos = row & 2047; pidx = pos;
                if (pos >= SEQ - W) dst = out + outP + ((size_t)(b * W + (pos - (SEQ - W))) * 2) * 1024; }
            else { const int rs = row - MP; const int b = rs >> 2, t = rs & 3; pidx = 2048 + t;
                if (row < MALL) dst = out + outS + ((size_t)(b * W + (W - 4 + t)) * 2) * 1024; }
            if (m3 == 2) {
                *(u32x4*)(Vg + (size_t)g * MPAD * D + (size_t)row * D + head * 128 + wc * 32 + 8 * fq) = pack8(v0, v1);
                if (dst) { float* p = dst + 1024 + head * 128 + wc * 32 + 8 * fq; *(f32x4*)p = v0; *(f32x4*)(p + 4) = v1; }
            } else {
                const int i0 = wc * 16 + 4 * fq;
                const f32x2* cs = rcs + (size_t)pidx * 64 + i0;
                const f32x4 cs01 = *(const f32x4*)cs, cs23 = *(const f32x4*)(cs + 2);
                f32x4 o1, o2;
                o1[0] = v0[0] * cs01[0] - v0[1] * cs01[1]; o2[0] = v0[1] * cs01[0] + v0[0] * cs01[1];
                o1[1] = v0[2] * cs01[2] - v0[3] * cs01[3]; o2[1] = v0[3] * cs01[2] + v0[2] * cs01[3];
                o1[2] = v1[0] * cs23[0] - v1[1] * cs23[1]; o2[2] = v1[1] * cs23[0] + v1[0] * cs23[1];
                o1[3] = v1[2] * cs23[2] - v1[3] * cs23[3]; o2[3] = v1[3] * cs23[2] + v1[2] * cs23[3];
                if (m3 == 0) {
                    const float sc = 0.08838834764831845f;
                    u16* q = Qg + (size_t)g * MPAD * D + (size_t)row * D + head * 128 + i0;
                    u32x2 w1, w2; w1.x = cvt_pk_bf16(o1[0] * sc, o1[1] * sc); w1.y = cvt_pk_bf16(o1[2] * sc, o1[3] * sc); w2.x = cvt_pk_bf16(o2[0] * sc, o2[1] * sc); w2.y = cvt_pk_bf16(o2[2] * sc, o2[3] * sc);
                    *(u32x2*)q = w1; *(u32x2*)(q + 64) = w2;
                } else {
                    u16* k = Kg + (size_t)g * MPAD * D + (size_t)row * D + head * 128 + i0;
                    u32x2 w1, w2; w1.x = cvt_pk_bf16(o1[0], o1[1]); w1.y = cvt_pk_bf16(o1[2], o1[3]); w2.x = cvt_pk_bf16(o2[0], o2[1]); w2.y = cvt_pk_bf16(o2[2], o2[3]);
                    *(u32x2*)k = w1; *(u32x2*)(k + 64) = w2;
                    if (dst) { float* p = dst + head * 128 + i0; *(f32x4*)p = o1; *(f32x4*)(p + 64) = o2; }
                }
            }
        EPI_LOOP_END
    }
};
struct EpiS5In {
    u16 *U, *GT; const float* SSQ;
    __device__ __forceinline__ void operator()(const Acc& acc, const Unit& u, int wr, int wc, int fr, int fq) const {
        const int seg = u.pn >> 2, cs0 = (u.pn & 3) * 256;
        EPI_LOOP_BEGIN_RS(SSQ)
            const size_t o = (size_t)row * D + cs0 + cb;
            if (seg == 0) *(u32x4*)(U + o) = pack8(v0, v1);
            else { f32x4 a, b;
#pragma unroll
                for (int j = 0; j < 4; ++j) { a[j] = siluf_(v0[j]); b[j] = siluf_(v1[j]); }
                *(u32x4*)(GT + o) = pack8(a, b); }
        EPI_LOOP_END
    }
};
struct EpiGlu {
    const u16 *Y, *GT; const float* bias; u16* O;
    __device__ __forceinline__ void operator()(const Acc& acc, const Unit& u, int wr, int wc, int fr, int fq) const {
        EPI_LOOP_BEGIN
            const int col = u.pn * 256 + cb; const size_t o = (size_t)row * D + col;
            const u32x4 yy = *(const u32x4*)(Y + o), gg = *(const u32x4*)(GT + o);
            const f32x4 b0 = *(const f32x4*)(bias + col), b1 = *(const f32x4*)(bias + col + 4);
            f32x4 a, b;
            a[0] = bflo(yy.x) * sigmoidf_(v0[0] + b0[0]) * bflo(gg.x); a[1] = bfhi(yy.x) * sigmoidf_(v0[1] + b0[1]) * bfhi(gg.x);
            a[2] = bflo(yy.y) * sigmoidf_(v0[2] + b0[2]) * bflo(gg.y); a[3] = bfhi(yy.y) * sigmoidf_(v0[3] + b0[3]) * bfhi(gg.y);
            b[0] = bflo(yy.z) * sigmoidf_(v1[0] + b1[0]) * bflo(gg.z); b[1] = bfhi(yy.z) * sigmoidf_(v1[1] + b1[1]) * bfhi(gg.z);
            b[2] = bflo(yy.w) * sigmoidf_(v1[2] + b1[2]) * bflo(gg.w); b[3] = bfhi(yy.w) * sigmoidf_(v1[3] + b1[3]) * bfhi(gg.w);
            *(u32x4*)(O + o) = pack8(a, b);
        EPI_LOOP_END
    }
};

constexpr int KVROWS0 = 32 * 124, KVROWS1 = 32 * 508, KVROWS2 = 32 * 2044, KVROWS = KVROWS0 + KVROWS1 + KVROWS2, KVSLICE = (KVROWS + 8) / 9;
__device__ __forceinline__ void kv_row_ptrs(const float* c3, const float* c4, const float* c5, float* out, int R, const f32x4*& src, f32x4*& dst) {
    const bool a = R < KVROWS0, bq = R < KVROWS0 + KVROWS1;
    const float* c = a ? c3 : (bq ? c4 : c5);
    const size_t oo = a ? OUT_KV128S : (bq ? OUT_KV512S : OUT_KV2048S);
    const int L = a ? 128 : (bq ? 512 : 2048);
    const int R2 = R - (a ? 0 : (bq ? KVROWS0 : KVROWS0 + KVROWS1));
    const int b = R2 / (L - 4), row = R2 - b * (L - 4);
    src = (const f32x4*)(c + ((size_t)b * L + row + 4) * 2048); dst = (f32x4*)(out + oo + ((size_t)b * L + row) * 2048);
}
__device__ __forceinline__ void kv_copy_slice(const Ctx& p, int k, int N) {
    const int nwg = (MPAD / 256) * (N / 256), rem = nwg % p.nb;
    int ii = p.bid, ni = p.nb;
    if (rem != 0) { if (p.bid < rem) return; ii = p.bid - rem; ni = p.nb - rem; }
    const int lo = k * KVSLICE, hi = (lo + KVSLICE) < KVROWS ? (lo + KVSLICE) : KVROWS;
    const float* c3 = p.in(3); const float* c4 = p.in(4); const float* c5 = p.in(5); float* po = p.out();
    int R = lo + ii;
    for (; R + 3 * ni < hi; R += 4 * ni) {
        const f32x4 *s0, *s1, *s2, *s3; f32x4 *d0, *d1, *d2, *d3;
        kv_row_ptrs(c3, c4, c5, po, R, s0, d0); kv_row_ptrs(c3, c4, c5, po, R + ni, s1, d1); kv_row_ptrs(c3, c4, c5, po, R + 2 * ni, s2, d2); kv_row_ptrs(c3, c4, c5, po, R + 3 * ni, s3, d3);
        const f32x4 a = __builtin_nontemporal_load(s0 + p.tid), b = __builtin_nontemporal_load(s1 + p.tid), c = __builtin_nontemporal_load(s2 + p.tid), e = __builtin_nontemporal_load(s3 + p.tid);
        __builtin_nontemporal_store(a, d0 + p.tid); __builtin_nontemporal_store(b, d1 + p.tid); __builtin_nontemporal_store(c, d2 + p.tid); __builtin_nontemporal_store(e, d3 + p.tid);
    }
    for (; R < hi; R += ni) { const f32x4* s0; f32x4* d0; kv_row_ptrs(c3, c4, c5, po, R, s0, d0); __builtin_nontemporal_store(__builtin_nontemporal_load(s0 + p.tid), d0 + p.tid); }
}
template <class Epi>
__device__ __forceinline__ void run_gemm(const Ctx& p, LAS unsigned char* lds, const u16* A, const u16* Bt, int N, const Epi& E, int kvslice) {
    pg8::Gemm g; g.A = A; g.Bt = Bt; g.M = MPAD; g.N = N; g.K = D;
    pg8::StaticOrder S; S.init(MPAD, N, p.nb, p.bid);
    pg8::gemm_phase<Epi, pg8::StaticOrder>(lds, g, S, E, p.tid);
    kv_copy_slice(p, kvslice, N);
}

__device__ __forceinline__ void sincos_d(double x, double& s, double& c) {
    const double k = rint(x * 0.15915494309189535);
    double r = fma(-k, 6.283185307179586, x); r = fma(-k, 2.4492935982947064e-16, r);
    const double r2 = r * r;
    double ts = r, tc = 1.0; s = r; c = 1.0;
#pragma unroll 1
    for (int i = 1; i <= 14; ++i) { tc = -tc * r2 / (double)((2 * i - 1) * (2 * i)); ts = -ts * r2 / (double)((2 * i) * (2 * i + 1)); c += tc; s += ts; }
}
__device__ __forceinline__ int wt_dst_row(int col, int mode) {
    if (mode == 2) { const int seg = col >> 10, x = col & 1023, y = x & 63; return (x >> 6) * 256 + 128 * (seg >> 1) + 32 * (y >> 4) + 8 * ((y >> 2) & 3) + 4 * (seg & 1) + (y & 3); }
    if (mode == 1 && col < 9216 && ((col >> 10) % 3) != 2) { const int l = col & 127; return (col & ~127) + 2 * (l & 63) + (l >> 6); }
    return col;
}
__device__ __forceinline__ void transpose_item(const float* W, int K, int N, u16* WT, int mode, LAS float* scr, int item, int lane, const float* nw) {
    const int nblk = N / 32, kb = item / nblk, nb = item % nblk, k0 = 64 * kb, n0 = 32 * nb;
    float tv[32];
#pragma unroll
    for (int i = 0; i < 32; ++i) tv[i] = __builtin_nontemporal_load(W + (size_t)(k0 + 2 * i + (lane >> 5)) * N + n0 + (lane & 31));
    if (nw) {
#pragma unroll
        for (int i = 0; i < 32; ++i) tv[i] *= nw[k0 + 2 * i + (lane >> 5)]; }
#pragma unroll
    for (int i = 0; i < 32; ++i) scr[(2 * i + (lane >> 5)) * 33 + (lane & 31)] = tv[i];
    LDS_WAIT();
    const int c = lane & 7;
#pragma unroll
    for (int j = 0; j < 4; ++j) { const int n = (lane >> 3) + 8 * j; const LAS float* s = scr + (8 * c) * 33 + n;
        u32x4 o; o.x = cvt_pk_bf16(s[0 * 33], s[1 * 33]); o.y = cvt_pk_bf16(s[2 * 33], s[3 * 33]); o.z = cvt_pk_bf16(s[4 * 33], s[5 * 33]); o.w = cvt_pk_bf16(s[6 * 33], s[7 * 33]);
        *(u32x4*)(WT + (size_t)wt_dst_row(n0 + n, mode) * K + k0 + 8 * c) = o; }
    LDS_WAIT();
}
__device__ __forceinline__ void norm_row(const float* xrow, const float* w, u16* hrow, float* xdst, int lane) {
    f32x4 v[4]; float s = 0.f;
#pragma unroll
    for (int j = 0; j < 4; ++j) { v[j] = ((const f32x4*)xrow)[lane + 64 * j]; s += (v[j][0] * v[j][0] + v[j][1] * v[j][1]) + (v[j][2] * v[j][2] + v[j][3] * v[j][3]); }
    const float rstd = rsqrtf(wave_sum(s) * (1.0f / D) + 1e-6f);
#pragma unroll
    for (int j = 0; j < 4; ++j) {
        if (xdst) ((f32x4*)xdst)[lane + 64 * j] = v[j];
        const f32x4 ww = ((const f32x4*)w)[lane + 64 * j];
        u32x2 o; o.x = cvt_pk_bf16(v[j][0] * rstd * ww[0], v[j][1] * rstd * ww[1]); o.y = cvt_pk_bf16(v[j][2] * rstd * ww[2], v[j][3] * rstd * ww[3]);
        ((u32x2*)hrow)[lane + 64 * j] = o;
    }
}
__device__ __forceinline__ void copy_f4(const float* src, float* dst, size_t n4, size_t i0, size_t stride) {
    const f32x4* s = (const f32x4*)src; f32x4* d = (f32x4*)dst;
    size_t i = i0;
    for (; i + 3 * stride < n4; i += 4 * stride) {
        const f32x4 a = __builtin_nontemporal_load(s + i), b = __builtin_nontemporal_load(s + i + stride), c = __builtin_nontemporal_load(s + i + 2 * stride), e = __builtin_nontemporal_load(s + i + 3 * stride);
        __builtin_nontemporal_store(a, d + i); __builtin_nontemporal_store(b, d + i + stride); __builtin_nontemporal_store(c, d + i + 2 * stride); __builtin_nontemporal_store(e, d + i + 3 * stride);
    }
    for (; i < n4; i += stride) __builtin_nontemporal_store(__builtin_nontemporal_load(s + i), d + i);
}
__device__ __forceinline__ void phase_prep(const Ctx& p, LAS unsigned char* lds) {
    const int tid = p.tid, lane = tid & 63, wave = tid >> 6;
    const int gw = p.bid * 8 + wave, NGW = p.nb * 8;
    const size_t gt = (size_t)p.bid * 512 + tid, NGT = (size_t)p.nb * 512;
    unsigned char* ws = p.ws();
#ifndef SKIP_A
    {
        LAS float* scr = (LAS float*)(lds + wave * 16384);
        constexpr int I_AIN = 16 * 128, I_SQ = 16 * 32, I_BIN = 16 * 320, I_CIN = 16 * 64;
        constexpr int NIT = 2 * I_AIN + 2 * I_SQ + I_BIN + I_SQ + I_CIN + I_SQ + I_SQ;
        for (int it = gw; it < NIT; it += NGW) {
            int r = it; const float* W; u16* WT; int N = 1024, mode = 0; const float* nw = nullptr;
            if (r < 2 * I_AIN) { const int l = r / I_AIN; W = p.in(9) + (size_t)l * 1024 * 4096; WT = (u16*)(ws + WS_WT_A_IN) + (size_t)l * 4096 * 1024; N = 4096; mode = 2; nw = p.in(7) + (l ? 3 * D : 0); r = r % I_AIN; }
            else if ((r -= 2 * I_AIN) < 2 * I_SQ) { const int l = r / I_SQ; W = p.in(12) + (size_t)l * 1024 * 1024; WT = (u16*)(ws + WS_WT_A_OUT) + (size_t)l * 1024 * 1024; r = r % I_SQ; }
            else if ((r -= 2 * I_SQ) < I_BIN) { W = p.in(13); WT = (u16*)(ws + WS_WT_B_IN); N = 10240; mode = 1; nw = p.in(7) + D; }
            else if ((r -= I_BIN) < I_SQ) { W = p.in(14); WT = (u16*)(ws + WS_WT_B_OUT); }
            else if ((r -= I_SQ) < I_CIN) { W = p.in(15); WT = (u16*)(ws + WS_WT_C_IN); N = 2048; nw = p.in(7) + 2 * D; }
            else if ((r -= I_CIN) < I_SQ) { W = p.in(24); WT = (u16*)(ws + WS_WT_C_GLU); }
            else { r -= I_SQ; W = p.in(26); WT = (u16*)(ws + WS_WT_C_OUT); }
            transpose_item(W, 1024, N, WT, mode, scr, r, lane, nw);
        }
    }
#endif
#ifndef SKIP_B
    for (int r = gw; r < MPAD; r += NGW) {
        float* xd = (float*)(ws + WS_X) + (size_t)r * D; u16* hd = (u16*)(ws + WS_H) + (size_t)r * D;
        if (r < MALL) { const float* xrow = r < MP ? p.in(0) + (size_t)r * D : p.in(1) + (size_t)(r - MP) * D; const float* w = p.in(7);
            f32x4 v[4]; float sq = 0.f;
#pragma unroll
            for (int j = 0; j < 4; ++j) { v[j] = __builtin_nontemporal_load((const f32x4*)xrow + lane + 64 * j); sq += (v[j][0] * v[j][0] + v[j][1] * v[j][1]) + (v[j][2] * v[j][2] + v[j][3] * v[j][3]); }
            sq = wave_sum(sq);
#pragma unroll
            for (int j = 0; j < 4; ++j) { u32x2 o; o.x = cvt_pk_bf16(v[j][0], v[j][1]); o.y = cvt_pk_bf16(v[j][2], v[j][3]); ((u32x2*)hd)[lane + 64 * j] = o; }
            (void)w;
            if (lane < 16) ((float*)(ws + WS_SSQ))[(size_t)r * 16 + lane] = lane == 0 ? sq : 0.f; }
        else {
#pragma unroll
            for (int j = 0; j < 4; ++j) { ((f32x4*)xd)[lane + 64 * j] = (f32x4){0.f, 0.f, 0.f, 0.f}; ((u32x2*)hd)[lane + 64 * j] = (u32x2){0u, 0u}; }
            u16* od = (u16*)(ws + WS_O) + (size_t)r * D;
#pragma unroll
            for (int j = 0; j < 4; ++j) ((u32x2*)od)[lane + 64 * j] = (u32x2){0u, 0u};
        }
    }
#endif
#ifndef SKIP_C
    for (size_t i = gt; i < (size_t)2052 * 64; i += NGT) {
        const int pi = (int)(i >> 6), fi = (int)(i & 63);
        const double pos = pi < 2048 ? (double)pi : (double)(PAST + pi - 2048);
        double f = 1.0; for (int k = 0; k < fi; ++k) f *= 0.8659643233600653;
        double s, c; sincos_d(pos * f, s, c);
        ((f32x2*)(ws + WS_RCS))[i] = (f32x2){(float)c, (float)s};
    }
    for (size_t i = gt; i < 1024; i += NGT) {
        const float l0 = p.in(10)[i], l1 = p.in(10)[1024 + i];
        ((float*)(ws + WS_LB))[i] = 0.f; ((float*)(ws + WS_LB))[1024 + i] = 1.0f / (1.0f + expf(l0 - l1));
    }
    for (size_t i = gt; i < 4096; i += NGT) {
        const int g = (int)(i >> 6), pp = (int)(i & 63);
        const double lre = fmin((double)p.in(16)[i], -1e-4), lim = (double)p.in(17)[i];
        const double dt = exp((double)p.in(23)[g]);
        const double mag = exp(lre * dt); double sn, cs; sincos_d(lim * dt, sn, cs);
        const double bre = mag * cs, bim = mag * sn;
        ((f32x2*)(ws + WS_LAM))[i] = (f32x2){(float)bre, (float)bim};
        const double den = lre * lre + lim * lim, xr = bre - 1.0;
        const double cre = (xr * lre + bim * lim) / den, cim = (bim * lre - xr * lim) / den;
        u16* SB = (u16*)(ws + WS_SB5); u16* SC = (u16*)(ws + WS_SC5);
        for (int c = 0; c < 16; ++c) {
            const double br = (double)p.in(18)[i * 16 + c], bi = (double)p.in(19)[i * 16 + c];
            const double vre = cre * br - cim * bi, vim = cre * bi + cim * br;
            const float cr = p.in(20)[((size_t)g * 16 + c) * 64 + pp], ci = p.in(21)[((size_t)g * 16 + c) * 64 + pp];
#pragma unroll
            for (int ri = 0; ri < 2; ++ri) {
                const int n = 2 * pp + ri;
                SB[((size_t)(g * 8 + (n >> 4)) * 64 + (c >> 2) * 16 + (n & 15)) * 4 + (c & 3)] = f2bf((float)(ri ? vim : vre));
                SC[((size_t)(g * 4 + (n >> 5)) * 64 + ((n >> 3) & 3) * 16 + c) * 8 + (n & 7)] = f2bf(ri ? -ci : cr);
            }
        }
    }
#endif
}

__device__ __forceinline__ void phase_norm(const Ctx& p, int layer) {
    const int lane = p.tid & 63, gw = p.bid * 8 + (p.tid >> 6), NGW = p.nb * 8;
    for (int r = gw; r < MALL; r += NGW)
        norm_row((const float*)(p.ws() + WS_X) + (size_t)r * D, p.in(7) + (size_t)layer * D, (u16*)(p.ws() + WS_H) + (size_t)r * D, nullptr, lane);
}
__device__ __forceinline__ void phase_final(const Ctx& p) {
    const int lane = p.tid & 63, gw = p.bid * 8 + (p.tid >> 6), NGW = p.nb * 8;
    for (int r = gw; r < MALL; r += NGW) {
        const u16* xrow = (const u16*)(p.ws() + WS_H) + (size_t)r * D;
        float* orow = p.out() + (r < MP ? OUT_YP + (size_t)r * D : OUT_YS + (size_t)(r - MP) * D);
        float ssq = lane < 16 ? ((const float*)(p.ws() + WS_SSQ))[(size_t)r * 16 + lane] : 0.f;
        ssq += __shfl_xor(ssq, 1); ssq += __shfl_xor(ssq, 2); ssq += __shfl_xor(ssq, 4); ssq += __shfl_xor(ssq, 8);
        const float rstd = rsqrtf(__shfl(ssq, 0) * (1.0f / D) + 1e-6f);
#pragma unroll
        for (int j = 0; j < 4; ++j) { const u32x2 xv = ((const u32x2*)xrow)[lane + 64 * j]; const f32x4 ww = ((const f32x4*)p.in(8))[lane + 64 * j];
            ((f32x4*)orow)[lane + 64 * j] = (f32x4){bflo(xv.x) * rstd * ww[0], bfhi(xv.x) * rstd * ww[1], bflo(xv.y) * rstd * ww[2], bfhi(xv.y) * rstd * ww[3]}; }
    }
}

__device__ __forceinline__ void phase_hgrn_local(const Ctx& p, LAS unsigned char* lds) {
    const int tid = p.tid, lane = tid & 63, w = tid >> 6, fr = lane & 15, fq = lane >> 4;
    LAS float* Tot = (LAS float*)lds;
    LAS u16* KhT = (LAS u16*)(lds + 2048);
    LAS u16* Vs = KhT + 128 * 136;
    const float* G = (const float*)(p.ws() + WS_G); const u16* KK = (const u16*)(p.ws() + WS_K); const u16* V = (const u16*)(p.ws() + WS_V);
    float* KVB = (float*)(p.ws() + WS_KVB); float* DEC = (float*)(p.ws() + WS_DEC);
    const int k = tid & 127, tq = tid >> 7;
    for (int task = p.bid; task < 1024; task += p.nb) {
        const int jb = task >> 3, h = task & 7; const size_t row0 = (size_t)jb * 128;
        float bl[32]; float run = 0.f; float kr[32];
#pragma unroll
        for (int i = 0; i < 32; ++i) { const size_t gi = (row0 + tq * 32 + i) * D + h * 128 + k; bl[i] = G[gi]; }
#pragma unroll
        for (int i = 0; i < 32; ++i) { kr[i] = 1.0f - __expf(bl[i]); run += bl[i]; bl[i] = run; }
        Tot[tq * 128 + k] = run;
#pragma unroll
        for (int i = 0; i < 4; ++i) { const int c = tid + 512 * i, r = c >> 4, ch = c & 15;
            *(LAS u32x4*)(Vs + r * 144 + ch * 8) = *(const u32x4*)(V + (row0 + r) * D + h * 128 + ch * 8); }
        __syncthreads();
        float off = 0.f, blast = 0.f;
#pragma unroll
        for (int q = 0; q < 4; ++q) { const float t = Tot[q * 128 + k]; blast += t; if (q < tq) off += t; }
#pragma unroll
        for (int i8 = 0; i8 < 4; ++i8) { float e[8];
#pragma unroll
            for (int i = 0; i < 8; ++i) e[i] = kr[i8 * 8 + i] * __expf(blast - (bl[i8 * 8 + i] + off));
            u32x4 wv; wv.x = cvt_pk_bf16(e[0], e[1]); wv.y = cvt_pk_bf16(e[2], e[3]); wv.z = cvt_pk_bf16(e[4], e[5]); wv.w = cvt_pk_bf16(e[6], e[7]);
            *(LAS u32x4*)(KhT + k * 136 + tq * 32 + i8 * 8) = wv; }
        if (tq == 0) DEC[(size_t)task * 128 + k] = __expf(blast);
        __syncthreads();
        f32x4 acc[8];
#pragma unroll
        for (int nt = 0; nt < 8; ++nt) acc[nt] = (f32x4){0.f, 0.f, 0.f, 0.f};
#pragma unroll
        for (int kk = 0; kk < 4; ++kk) {
            const bf16x8 a = *(const LAS bf16x8*)(KhT + (16 * w + fr) * 136 + 32 * kk + fq * 8);
#pragma unroll
            for (int nt = 0; nt < 8; ++nt) { const bf16x8 b = tr_frag8(Vs, 144, 32 * kk, 16 * nt, lane); acc[nt] = MFMA32(a, b, acc[nt]); }
        }
        float* dst = KVB + (size_t)task * 16384;
#pragma unroll
        for (int nt = 0; nt < 8; ++nt)
#pragma unroll
            for (int j = 0; j < 4; ++j) dst[(16 * w + fq * 4 + j) * 128 + 16 * nt + fr] = acc[nt][j];
        __syncthreads();
    }
}
__device__ __forceinline__ void phase_hgrn_scan(const Ctx& p, int j) {
    const size_t gt = (size_t)p.bid * 512 + p.tid, NGT = (size_t)p.nb * 512;
    const float* KVB = (const float*)(p.ws() + WS_KVB); const float* DEC = (const float*)(p.ws() + WS_DEC); float* SST = (float*)(p.ws() + WS_SST);
    for (size_t it = gt; it < (size_t)64 * 4096; it += NGT) {
        const int seq = (int)(it >> 12), e4 = (int)(it & 4095), b = seq >> 3, h = seq & 7, k = e4 >> 5;
        f32x4 S = (f32x4){0.f, 0.f, 0.f, 0.f};
#pragma unroll 4
        for (int jb = 0; jb < 16; ++jb) {
            const size_t task = (size_t)(b * 16 + jb) * 8 + h;
            *(f32x4*)(SST + task * 16384 + e4 * 4) = S;
            const float d = DEC[task * 128 + k];
            S = S * d + *(const f32x4*)(KVB + task * 16384 + e4 * 4);
        }
        *(f32x4*)(p.out() + OUT_HGP + ((size_t)(j * 8 + b) * 8 + h) * 16384 + e4 * 4) = S;
    }
}
__device__ __forceinline__ void phase_hgrn_out(const Ctx& p, LAS unsigned char* lds, int j) {
    const int tid = p.tid, lane = tid & 63, w = tid >> 6, fr = lane & 15, fq = lane >> 4;
    LAS u16* QtT = (LAS u16*)lds;
    LAS u16* KtT = QtT + 128 * 40;
    LAS u16* KhT = KtT + 128 * 40;
    LAS u16* Vs = KhT + 128 * 40;
    LAS u16* SbT = Vs + 32 * 144;
    LAS u16* Ps = SbT + 128 * 136;
    LAS float* Ob = (LAS float*)(Ps + 32 * 40);
    LAS float* Dec = Ob + 32 * 132;
    LAS float* Tot = Dec + 128;
    const float* G = (const float*)(p.ws() + WS_G); const u16* Q = (const u16*)(p.ws() + WS_Q); const u16* KK = (const u16*)(p.ws() + WS_K); const u16* V = (const u16*)(p.ws() + WS_V);
    const u16* GT = (const u16*)(p.ws() + WS_GT); u16* O = (u16*)(p.ws() + WS_O);
    const float* SST = (const float*)(p.ws() + WS_SST);
    const float* onw = p.in(11) + (size_t)j * 1024;
    const int k = tid & 127, tq = tid >> 7;
    {
        const int ntask = (1024 - p.bid + p.nb - 1) / p.nb, nit = ntask * 4;
        float gC[8]; u16 qC[8]; u32x4 vC, gtC;
#define HG_LOAD(it_, g_, q_, v_, gt_) do { const int tk_ = p.bid + ((it_) >> 2) * p.nb; const size_t r0_ = (size_t)(tk_ >> 3) * 128 + ((it_) & 3) * 32; const int hh_ = tk_ & 7; \
        _Pragma("unroll") for (int i = 0; i < 8; ++i) { const size_t gi_ = (r0_ + tq * 8 + i) * D + hh_ * 128 + k; g_[i] = G[gi_]; q_[i] = Q[gi_]; } \
        { const size_t gi_ = (r0_ + (tid >> 4)) * D + hh_ * 128 + (tid & 15) * 8; v_ = *(const u32x4*)(V + gi_); gt_ = *(const u32x4*)(GT + gi_); } } while (0)
        if (nit > 0) HG_LOAD(0, gC, qC, vC, gtC);
        f32x4 S[8];
#pragma unroll 1
        for (int it = 0; it < nit; ++it) {
            const int task = p.bid + (it >> 2) * p.nb, sc = it & 3, jb = task >> 3, h = task & 7;
            const size_t row0 = (size_t)jb * 128 + sc * 32;
            if (sc == 0) { const float* src = SST + (size_t)task * 16384;
#pragma unroll
                for (int nt = 0; nt < 8; ++nt)
#pragma unroll
                    for (int jj = 0; jj < 4; ++jj) S[nt][jj] = src[(16 * w + fq * 4 + jj) * 128 + 16 * nt + fr]; }
            float bl[8]; float run = 0.f;
#pragma unroll
            for (int i = 0; i < 8; ++i) { run += gC[i]; bl[i] = run; }
            Tot[tq * 128 + k] = run;
            { const int r = tid >> 4, ch = tid & 15; *(LAS u32x4*)(Vs + r * 144 + ch * 8) = vC; }
#pragma unroll
            for (int nt = 0; nt < 8; ++nt) { u32x2 sw; sw.x = cvt_pk_bf16(S[nt][0], S[nt][1]); sw.y = cvt_pk_bf16(S[nt][2], S[nt][3]);
                *(LAS u32x2*)(SbT + (16 * nt + fr) * 136 + 16 * w + fq * 4) = sw; }
            float gN[8]; u16 qN[8]; u32x4 vN, gtN;
            { const int itn = it + 1 < nit ? it + 1 : it; HG_LOAD(itn, gN, qN, vN, gtN); }
            __syncthreads();
            float off = 0.f, blast = 0.f;
#pragma unroll
            for (int q = 0; q < 4; ++q) { const float t = Tot[q * 128 + k]; blast += t; if (q < tq) off += t; }
            { float eq[8], ek[8], eh[8];
#pragma unroll
              for (int i = 0; i < 8; ++i) { const float b = bl[i] + off; const float qq = bf2f(qC[i]), kk = 1.0f - __expf(gC[i]);
                  eq[i] = qq * __expf(b); ek[i] = kk * __expf(fminf(-b, 80.f)); eh[i] = kk * __expf(blast - b); }
              u32x4 wq, wk, wh;
              wq.x = cvt_pk_bf16(eq[0], eq[1]); wq.y = cvt_pk_bf16(eq[2], eq[3]); wq.z = cvt_pk_bf16(eq[4], eq[5]); wq.w = cvt_pk_bf16(eq[6], eq[7]);
              wk.x = cvt_pk_bf16(ek[0], ek[1]); wk.y = cvt_pk_bf16(ek[2], ek[3]); wk.z = cvt_pk_bf16(ek[4], ek[5]); wk.w = cvt_pk_bf16(ek[6], ek[7]);
              wh.x = cvt_pk_bf16(eh[0], eh[1]); wh.y = cvt_pk_bf16(eh[2], eh[3]); wh.z = cvt_pk_bf16(eh[4], eh[5]); wh.w = cvt_pk_bf16(eh[6], eh[7]);
              *(LAS u32x4*)(QtT + k * 40 + tq * 8) = wq; *(LAS u32x4*)(KtT + k * 40 + tq * 8) = wk; *(LAS u32x4*)(KhT + k * 40 + tq * 8) = wh; }
            if (tq == 0) Dec[k] = __expf(blast);
            __syncthreads();
            if (w < 4) {
                const int mt = w >> 1, st = w & 1;
                f32x4 sacc = (f32x4){0.f, 0.f, 0.f, 0.f};
                if (!(mt == 0 && st == 1)) {
#pragma unroll
                    for (int kk = 0; kk < 4; ++kk) {
                        const bf16x8 a = tr_frag8(QtT, 40, 32 * kk, 16 * mt, lane);
                        const bf16x8 b = tr_frag8(KtT, 40, 32 * kk, 16 * st, lane);
                        sacc = MFMA32(a, b, sacc);
                    }
                }
#pragma unroll
                for (int jj = 0; jj < 4; ++jj) { const int t = 16 * mt + fq * 4 + jj, s2 = 16 * st + fr; Ps[t * 40 + s2] = f2bf(s2 <= t ? sacc[jj] : 0.f); }
            }
            __syncthreads();
            { const int mt = w & 1, ntp = w >> 1;
#pragma unroll
              for (int q2 = 0; q2 < 2; ++q2) { const int nt = ntp * 2 + q2;
                  f32x4 oacc = (f32x4){0.f, 0.f, 0.f, 0.f};
                  { const bf16x8 a = *(const LAS bf16x8*)(Ps + (16 * mt + fr) * 40 + fq * 8); const bf16x8 b = tr_frag8(Vs, 144, 0, 16 * nt, lane); oacc = MFMA32(a, b, oacc); }
#pragma unroll
                  for (int kk = 0; kk < 4; ++kk) { const bf16x8 a = tr_frag8(QtT, 40, 32 * kk, 16 * mt, lane); const bf16x8 b = *(const LAS bf16x8*)(SbT + (16 * nt + fr) * 136 + 32 * kk + fq * 8); oacc = MFMA32(a, b, oacc); }
#pragma unroll
                  for (int jj = 0; jj < 4; ++jj) Ob[(16 * mt + fq * 4 + jj) * 132 + 16 * nt + fr] = oacc[jj]; } }
            { float dd[4];
#pragma unroll
              for (int jj = 0; jj < 4; ++jj) dd[jj] = Dec[16 * w + fq * 4 + jj];
              const bf16x8 a = *(const LAS bf16x8*)(KhT + (16 * w + fr) * 40 + fq * 8);
#pragma unroll
              for (int nt = 0; nt < 8; ++nt) { const bf16x8 b = tr_frag8(Vs, 144, 0, 16 * nt, lane); f32x4 c;
#pragma unroll
                  for (int jj = 0; jj < 4; ++jj) c[jj] = S[nt][jj] * dd[jj];
                  S[nt] = MFMA32(a, b, c); } }
            __syncthreads();
            { const int t = tid >> 4, cg8 = tid & 15; const LAS float* orow = Ob + t * 132 + cg8 * 8;
              const f32x4 a = *(const LAS f32x4*)orow, b = *(const LAS f32x4*)(orow + 4);
              float ss = (a[0] * a[0] + a[1] * a[1]) + (a[2] * a[2] + a[3] * a[3]) + (b[0] * b[0] + b[1] * b[1]) + (b[2] * b[2] + b[3] * b[3]);
              ss += __shfl_xor(ss, 1); ss += __shfl_xor(ss, 2); ss += __shfl_xor(ss, 4); ss += __shfl_xor(ss, 8);
              const float rstd = rsqrtf(ss * (1.0f / 128.0f) + 1e-6f);
              const size_t gi = (row0 + t) * D + h * 128 + cg8 * 8;
              const f32x4 w0 = *(const f32x4*)(onw + h * 128 + cg8 * 8), w1 = *(const f32x4*)(onw + h * 128 + cg8 * 8 + 4);
              const u32x4 gg = gtC;
              f32x4 oa, ob;
              oa[0] = a[0] * rstd * w0[0] * bflo(gg.x); oa[1] = a[1] * rstd * w0[1] * bfhi(gg.x); oa[2] = a[2] * rstd * w0[2] * bflo(gg.y); oa[3] = a[3] * rstd * w0[3] * bfhi(gg.y);
              ob[0] = b[0] * rstd * w1[0] * bflo(gg.z); ob[1] = b[1] * rstd * w1[1] * bfhi(gg.z); ob[2] = b[2] * rstd * w1[2] * bflo(gg.w); ob[3] = b[3] * rstd * w1[3] * bfhi(gg.w);
              *(u32x4*)(O + gi) = pack8(oa, ob); }
#pragma unroll
            for (int i = 0; i < 8; ++i) { gC[i] = gN[i]; qC[i] = qN[i]; }
            vC = vN; gtC = gtN;
        }
        __syncthreads();
#undef HG_LOAD
    }
    for (int task = p.bid; task < HG_NS; task += p.nb) {
        {
            const int sb = task >> 3, h = task & 7;
            LAS float* fs = (LAS float*)lds; LAS float* ks = fs + 128; LAS float* qs = ks + 128; LAS float* red = qs + 128;
            LAS float* rs = red + 512;
            const int v = tid & 127, kq = tid >> 7;
            const float* s0 = p.in(2) + ((size_t)(j * 32 + sb) * 8 + h) * 16384;
            float S[32];
#pragma unroll
            for (int i = 0; i < 32; ++i) { S[i] = s0[(kq * 32 + i) * 128 + v]; if ((i & 7) == 7) asm volatile("" ::: "memory"); }
#pragma unroll 1
            for (int t = 0; t < 4; ++t) {
                const size_t row = (size_t)MP + sb * 4 + t; const size_t gi = row * D + h * 128;
                if (tid < 128) { const float f = __expf(G[gi + tid]); fs[tid] = f; ks[tid] = 1.0f - f; qs[tid] = bf2f(Q[gi + tid]); }
                const float vv = bf2f(V[gi + v]);
                __syncthreads();
                float po = 0.f;
#pragma unroll
                for (int i = 0; i < 32; ++i) { const int kk = kq * 32 + i; S[i] = fs[kk] * S[i] + ks[kk] * vv; po += qs[kk] * S[i]; if ((i & 7) == 7) asm volatile("" ::: "memory"); }
                red[kq * 128 + v] = po;
                __syncthreads();
                float o = 0.f;
                if (tid < 128) { o = (red[v] + red[128 + v]) + (red[256 + v] + red[384 + v]); const float ss = wave_sum(o * o); if (lane == 0) rs[w] = ss; }
                __syncthreads();
                if (tid < 128) { const float rstd = rsqrtf((rs[0] + rs[1]) * (1.0f / 128.0f) + 1e-6f);
                    O[gi + v] = f2bf(o * rstd * onw[h * 128 + v] * bf2f(GT[gi + v])); }
                __syncthreads();
            }
            float* d0 = p.out() + OUT_HGS + ((size_t)(j * 32 + sb) * 8 + h) * 16384;
#pragma unroll
            for (int i = 0; i < 32; ++i) { d0[(kq * 32 + i) * 128 + v] = S[i]; if ((i & 7) == 7) asm volatile("" ::: "memory"); }
        }
    }
}

__device__ __forceinline__ void phase_attn(const Ctx& p, LAS unsigned char* lds) {
    const int tid = p.tid, lane = tid & 63, w = tid >> 6, fr = lane & 15, fq = lane >> 4;
    LAS u16* Ks = (LAS u16*)lds;
    LAS u16* Vs = Ks + 256 * 136;
    const u16* Qg = (const u16*)(p.ws() + WS_Q); const u16* Kg = (const u16*)(p.ws() + WS_K); const u16* Vg = (const u16*)(p.ws() + WS_V);
    u16* OG = (u16*)(p.ws() + WS_OG); float* LSE = (float*)(p.ws() + WS_LSE);
    {
        u32x4 kR[8], vR[8]; bf16x8 qN[4];
#define AT_DECODE(task_) const int g_ = (task_) >> 10, rem_ = (task_) & 1023, b_ = rem_ >> 7, h_ = (rem_ >> 4) & 7, q16_ = rem_ & 15; \
        const int d_ = 1 << (2 * g_), nblk_ = 16 >> (2 * g_), r_ = q16_ / nblk_, j_ = q16_ % nblk_;
#define AT_LOAD(task_) do { AT_DECODE(task_) \
        const u16* Kb_ = Kg + (size_t)g_ * MPAD * D + (size_t)b_ * SEQ * D + h_ * 128; const u16* Vb_ = Vg + (size_t)g_ * MPAD * D + (size_t)b_ * SEQ * D + h_ * 128; \
        _Pragma("unroll") for (int i = 0; i < 8; ++i) { const int c = tid + 512 * i, kl = c >> 4, ch = c & 15; const int idx = 128 * (j_ - 1) + kl; \
            kR[i] = (u32x4){0u, 0u, 0u, 0u}; vR[i] = (u32x4){0u, 0u, 0u, 0u}; \
            if (idx >= 0) { const size_t off = (size_t)(idx * d_ + r_) * D + ch * 8; kR[i] = *(const u32x4*)(Kb_ + off); vR[i] = *(const u32x4*)(Vb_ + off); } } \
        const size_t qrow_ = (size_t)b_ * SEQ + (size_t)(128 * j_ + 16 * w + fr) * d_ + r_; \
        _Pragma("unroll") for (int kk = 0; kk < 4; ++kk) qN[kk] = *(const bf16x8*)(Qg + (size_t)g_ * MPAD * D + qrow_ * D + h_ * 128 + kk * 32 + fq * 8); } while (0)
        const int lbid = (p.nb & 7) == 0 ? (p.bid & 7) * (p.nb >> 3) + (p.bid >> 3) : p.bid;
        if (lbid < 3072) AT_LOAD(lbid);
#pragma unroll 1
        for (int task = lbid; task < 3072; task += p.nb) {
            AT_DECODE(task)
            const int g = g_, b = b_, h = h_, d = d_, r = r_, j = j_;
#pragma unroll
            for (int i = 0; i < 8; ++i) { const int c = tid + 512 * i, kl = c >> 4, ch = c & 15;
                *(LAS u32x4*)(Ks + kl * 136 + ch * 8) = kR[i]; *(LAS u32x4*)(Vs + kl * 144 + ch * 8) = vR[i]; }
            bf16x8 qf[4];
#pragma unroll
            for (int kk = 0; kk < 4; ++kk) qf[kk] = qN[kk];
            const size_t qrow = (size_t)b * SEQ + (size_t)(128 * j + 16 * w + fr) * d + r;
            __syncthreads();
            if (task + p.nb < 3072) AT_LOAD(task + p.nb);
            f32x4 st[9]; float mx = -1e30f;
#pragma unroll
            for (int kt = 0; kt < 9; ++kt) {
                f32x4 a = (f32x4){0.f, 0.f, 0.f, 0.f};
#pragma unroll
                for (int kk = 0; kk < 4; ++kk) { const bf16x8 kf = *(const LAS bf16x8*)(Ks + (16 * (w + kt) + fr) * 136 + kk * 32 + fq * 8); a = MFMA32(kf, qf[kk], a); }
#pragma unroll
                for (int jj = 0; jj < 4; ++jj) { const int rel = 128 + fr - 16 * kt - fq * 4 - jj; const int kl = 16 * (w + kt) + fq * 4 + jj;
                    const bool ok = rel >= 0 && rel <= 128 && (j > 0 || kl >= 128);
                    a[jj] = ok ? a[jj] : -1e30f; mx = fmaxf(mx, a[jj]); }
                st[kt] = a;
            }
            mx = fmaxf(mx, __shfl_xor(mx, 16)); mx = fmaxf(mx, __shfl_xor(mx, 32));
            float ls = 0.f;
#pragma unroll
            for (int kt = 0; kt < 9; ++kt)
#pragma unroll
                for (int jj = 0; jj < 4; ++jj) { const float e = __expf(st[kt][jj] - mx); st[kt][jj] = e; ls += e; }
            ls += __shfl_xor(ls, 16); ls += __shfl_xor(ls, 32);
            f32x4 oacc[8];
#pragma unroll
            for (int dt = 0; dt < 8; ++dt) oacc[dt] = (f32x4){0.f, 0.f, 0.f, 0.f};
#pragma unroll
            for (int kt = 0; kt < 8; kt += 2) {
                u32x4 pw; pw.x = cvt_pk_bf16(st[kt][0], st[kt][1]); pw.y = cvt_pk_bf16(st[kt][2], st[kt][3]); pw.z = cvt_pk_bf16(st[kt + 1][0], st[kt + 1][1]); pw.w = cvt_pk_bf16(st[kt + 1][2], st[kt + 1][3]);
                const bf16x8 pb = __builtin_bit_cast(bf16x8, pw);
#pragma unroll
                for (int dt = 0; dt < 8; ++dt) { const s4 v0 = tr_frag4(Vs, 144, 16 * (w + kt), 16 * dt, lane), v1 = tr_frag4(Vs, 144, 16 * (w + kt + 1), 16 * dt, lane);
                    const bf16x8 vf = (bf16x8){v0[0], v0[1], v0[2], v0[3], v1[0], v1[1], v1[2], v1[3]}; oacc[dt] = MFMA32(vf, pb, oacc[dt]); }
            }
            { u32x2 pw; pw.x = cvt_pk_bf16(st[8][0], st[8][1]); pw.y = cvt_pk_bf16(st[8][2], st[8][3]);
              const s4 pb = __builtin_bit_cast(s4, pw);
#pragma unroll
              for (int dt = 0; dt < 8; ++dt) { const s4 vf = tr_frag4(Vs, 144, 16 * (w + 8), 16 * dt, lane); oacc[dt] = MFMA16(vf, pb, oacc[dt]); } }
            const float inv = 1.0f / ls;
            u16* od = OG + (size_t)g * MPAD * D + qrow * D + h * 128;
#pragma unroll
            for (int dt = 0; dt < 8; ++dt) { u32x2 o; o.x = cvt_pk_bf16(oacc[dt][0] * inv, oacc[dt][1] * inv); o.y = cvt_pk_bf16(oacc[dt][2] * inv, oacc[dt][3] * inv);
                *(u32x2*)(od + 16 * dt + fq * 4) = o; }
            if (fq == 0) LSE[((size_t)g * MP + qrow) * 8 + h] = mx + __logf(ls);
            __syncthreads();
        }
#undef AT_LOAD
#undef AT_DECODE
    }
}
__device__ __forceinline__ void phase_merge(const Ctx& p, LAS unsigned char* lds) {
    const int tid = p.tid, lane = tid & 63, w = tid >> 6;
    const u16* Qg = (const u16*)(p.ws() + WS_Q); const u16* Kg = (const u16*)(p.ws() + WS_K); const u16* Vg = (const u16*)(p.ws() + WS_V);
    (void)Kg; (void)Vg;
    {
        LAS float* sc = (LAS float*)lds + w * 400;
        const int gw = w * p.nb + p.bid, NGW = p.nb * 8;
        const int sub = lane & 15, ksl = lane >> 4;
        for (int task = gw; task < 1024; task += NGW) {
            const int b = task >> 5, t = (task >> 3) & 3, h = task & 7;
            const size_t row = (size_t)MP + b * 4 + t;
            float og[3][8], lse[3];
#pragma unroll
            for (int g = 0; g < 3; ++g) {
                const int L = g == 0 ? 128 : (g == 1 ? 512 : 2048), d = g == 0 ? 1 : (g == 1 ? 4 : 16);
                const size_t outS = g == 0 ? OUT_KV128S : (g == 1 ? OUT_KV512S : OUT_KV2048S);
                const float* cache = p.in(3 + g) + (size_t)b * L * 2048 + h * 128 + sub * 8;
                const float* newr = p.out() + outS + ((size_t)b * L - 4) * 2048 + h * 128 + sub * 8;
                float q[8];
                { const u32x4 qq = *(const u32x4*)(Qg + (size_t)g * MPAD * D + row * D + h * 128 + sub * 8);
                  q[0] = bflo(qq.x); q[1] = bfhi(qq.x); q[2] = bflo(qq.y); q[3] = bfhi(qq.y); q[4] = bflo(qq.z); q[5] = bfhi(qq.z); q[6] = bflo(qq.w); q[7] = bfhi(qq.w); }
                LAS float* scg = sc + g * 132;
#pragma unroll 1
                for (int rb = 0; rb < 3; ++rb) {
                    f32x4 ka[12], kc[12];
#pragma unroll
                    for (int u = 0; u < 12; ++u) { int r = (rb * 12 + u) * 4 + ksl; r = r > 128 ? 128 : r; const int idx = L + t - d * r;
                        const float* kp = (idx >= L ? newr : cache) + (size_t)idx * 2048; ka[u] = *(const f32x4*)kp; kc[u] = *(const f32x4*)(kp + 4); }
#pragma unroll
                    for (int u = 0; u < 12; ++u) { const int r = (rb * 12 + u) * 4 + ksl;
                        float sv = (q[0] * ka[u][0] + q[1] * ka[u][1]) + (q[2] * ka[u][2] + q[3] * ka[u][3]) + (q[4] * kc[u][0] + q[5] * kc[u][1]) + (q[6] * kc[u][2] + q[7] * kc[u][3]);
                        sv += __shfl_xor(sv, 1); sv += __shfl_xor(sv, 2); sv += __shfl_xor(sv, 4); sv += __shfl_xor(sv, 8);
                        if (sub == 0 && r < 132) scg[r] = (r <= 128) ? sv : -1e30f; }
                }
                LDS_WAIT();
                float mx = fmaxf(fmaxf(scg[lane], scg[64 + lane]), lane < 4 ? scg[128 + lane] : -1e30f);
                mx = wave_max(mx);
                float e0 = __expf(scg[lane] - mx), e1 = __expf(scg[64 + lane] - mx), e2 = lane < 4 ? __expf(scg[128 + lane] - mx) : 0.f;
                const float lsum = wave_sum(e0 + e1 + e2);
                LDS_WAIT();
                scg[lane] = e0; scg[64 + lane] = e1; if (lane < 4) scg[128 + lane] = e2;
                LDS_WAIT();
                lse[g] = mx + __logf(lsum);
                float o[8];
#pragma unroll
                for (int e = 0; e < 8; ++e) o[e] = 0.f;
#pragma unroll 1
                for (int rb = 0; rb < 3; ++rb) {
                    f32x4 va[12], vc[12];
#pragma unroll
                    for (int u = 0; u < 12; ++u) { int r = (rb * 12 + u) * 4 + ksl; r = r > 128 ? 128 : r; const int idx = L + t - d * r;
                        const float* vp = (idx >= L ? newr : cache) + (size_t)idx * 2048 + 1024; va[u] = *(const f32x4*)vp; vc[u] = *(const f32x4*)(vp + 4); }
#pragma unroll
                    for (int u = 0; u < 12; ++u) { const int r = (rb * 12 + u) * 4 + ksl; const float pr = r < 132 ? scg[r] : 0.f;
#pragma unroll
                        for (int e = 0; e < 4; ++e) { o[e] += pr * va[u][e]; o[4 + e] += pr * vc[u][e]; } }
                }
                const float inv = 1.0f / lsum;
#pragma unroll
                for (int e = 0; e < 8; ++e) { float x = o[e]; x += __shfl_xor(x, 16); x += __shfl_xor(x, 32); og[g][e] = x * inv; }
                LDS_WAIT();
            }
            const float mm = fmaxf(lse[0], fmaxf(lse[1], lse[2]));
            const float w0 = __expf(lse[0] - mm), w1 = __expf(lse[1] - mm), w2 = __expf(lse[2] - mm); const float wi = 1.0f / (w0 + w1 + w2);
            if (ksl == 0) {
                const size_t gi = row * D + h * 128 + sub * 8;
                const u32x4 gg = *(const u32x4*)((const u16*)(p.ws() + WS_GT) + gi);
                float gt[8] = {siluf_(bflo(gg.x)), siluf_(bfhi(gg.x)), siluf_(bflo(gg.y)), siluf_(bfhi(gg.y)), siluf_(bflo(gg.z)), siluf_(bfhi(gg.z)), siluf_(bflo(gg.w)), siluf_(bfhi(gg.w))};
                f32x4 a, c;
#pragma unroll
                for (int e = 0; e < 4; ++e) { a[e] = (w0 * og[0][e] + w1 * og[1][e] + w2 * og[2][e]) * wi * gt[e]; c[e] = (w0 * og[0][4 + e] + w1 * og[1][4 + e] + w2 * og[2][4 + e]) * wi * gt[4 + e]; }
                *(u32x4*)((u16*)(p.ws() + WS_O) + gi) = pack8(a, c);
            }
        }
    }
    const u16* OG = (const u16*)(p.ws() + WS_OG); const float* LSE = (const float*)(p.ws() + WS_LSE); const u16* GT = (const u16*)(p.ws() + WS_GT); u16* O = (u16*)(p.ws() + WS_O);
    const int gpb = (MP * 128 / 64) / p.nb;
    if (w >= 4) {
        const int big = gpb / 4, g0 = (w - 4) * big, g1 = (w == 7) ? gpb : g0 + big;
#pragma unroll 1
        for (int grp = g0; grp < g1; grp += 4) {
            float l0[4], l1[4], l2[4]; u32x4 a[4], b[4], c[4], gg[4]; size_t gi[4];
#pragma unroll
            for (int q = 0; q < 4; ++q) { const int gq = (grp + q < g1) ? grp + q : g1 - 1; const size_t it = ((size_t)p.bid * gpb + gq) * 64 + lane;
                const size_t row = it >> 7; const int c8 = (int)(it & 127), h = c8 >> 4;
                l0[q] = LSE[row * 8 + h]; l1[q] = LSE[((size_t)MP + row) * 8 + h]; l2[q] = LSE[((size_t)2 * MP + row) * 8 + h];
                gi[q] = row * D + c8 * 8;
                a[q] = *(const u32x4*)(OG + gi[q]); b[q] = *(const u32x4*)(OG + (size_t)MPAD * D + gi[q]); c[q] = *(const u32x4*)(OG + (size_t)2 * MPAD * D + gi[q]); gg[q] = *(const u32x4*)(GT + gi[q]); }
#pragma unroll
            for (int q = 0; q < 4; ++q) {
                const float mm = fmaxf(l0[q], fmaxf(l1[q], l2[q])); float w0 = __expf(l0[q] - mm), w1 = __expf(l1[q] - mm), w2 = __expf(l2[q] - mm); const float wi = 1.0f / (w0 + w1 + w2); w0 *= wi; w1 *= wi; w2 *= wi;
                f32x4 x, y;
                x[0] = (w0 * bflo(a[q].x) + w1 * bflo(b[q].x) + w2 * bflo(c[q].x)) * siluf_(bflo(gg[q].x)); x[1] = (w0 * bfhi(a[q].x) + w1 * bfhi(b[q].x) + w2 * bfhi(c[q].x)) * siluf_(bfhi(gg[q].x));
                x[2] = (w0 * bflo(a[q].y) + w1 * bflo(b[q].y) + w2 * bflo(c[q].y)) * siluf_(bflo(gg[q].y)); x[3] = (w0 * bfhi(a[q].y) + w1 * bfhi(b[q].y) + w2 * bfhi(c[q].y)) * siluf_(bfhi(gg[q].y));
                y[0] = (w0 * bflo(a[q].z) + w1 * bflo(b[q].z) + w2 * bflo(c[q].z)) * siluf_(bflo(gg[q].z)); y[1] = (w0 * bfhi(a[q].z) + w1 * bfhi(b[q].z) + w2 * bfhi(c[q].z)) * siluf_(bfhi(gg[q].z));
                y[2] = (w0 * bflo(a[q].w) + w1 * bflo(b[q].w) + w2 * bflo(c[q].w)) * siluf_(bflo(gg[q].w)); y[3] = (w0 * bfhi(a[q].w) + w1 * bfhi(b[q].w) + w2 * bfhi(c[q].w)) * siluf_(bfhi(gg[q].w));
                *(u32x4*)(O + gi[q]) = pack8(x, y);
            }
        }
    }
}

constexpr int S5_NSEG = 4, S5_SEGLEN = SEQ / S5_NSEG;
template <bool FULL>
__device__ __forceinline__ void s5_run(const Ctx& p, LAS float* BU, LAS u16* Xs, int g, size_t row0, int T, float& xr, float& xi, int lane) {
    const int fr = lane & 15, fq = lane >> 4;
    const u16* U = (const u16*)(p.ws() + WS_V); u16* Y = (u16*)(p.ws() + WS_OG);
    s4 bfr[8]; bf16x8 cfr[4];
#pragma unroll
    for (int nt = 0; nt < 8; ++nt) bfr[nt] = *(const s4*)((const u16*)(p.ws() + WS_SB5) + ((size_t)(g * 8 + nt) * 64 + lane) * 4);
    if (FULL) {
#pragma unroll
        for (int kk = 0; kk < 4; ++kk) cfr[kk] = *(const bf16x8*)((const u16*)(p.ws() + WS_SC5) + ((size_t)(g * 4 + kk) * 64 + lane) * 8);
    }
    const f32x2 lam = ((const f32x2*)(p.ws() + WS_LAM))[g * 64 + lane];
    const float dsk = FULL ? p.in(22)[g * 16 + fr] : 0.f;
    s4 ua = *(const s4*)(U + (row0 + fr) * D + g * 16 + fq * 4);
    u16 us[4] = {0, 0, 0, 0};
    if (FULL) {
#pragma unroll
        for (int jj = 0; jj < 4; ++jj) us[jj] = U[(row0 + fq * 4 + jj) * D + g * 16 + fr];
    }
#pragma unroll 1
    for (int t0 = 0; t0 < T; t0 += 16) {
        const int nv = (T - t0) < 16 ? (T - t0) : 16;
        const int tn = (t0 + 16 < T) ? t0 + 16 : t0;
        const s4 ua_n = *(const s4*)(U + (row0 + tn + fr) * D + g * 16 + fq * 4);
        u16 us_n[4] = {0, 0, 0, 0};
        if (FULL) {
#pragma unroll
            for (int jj = 0; jj < 4; ++jj) us_n[jj] = U[(row0 + tn + fq * 4 + jj) * D + g * 16 + fr];
        }
#pragma unroll
        for (int nt = 0; nt < 8; ++nt) { const f32x4 bu = MFMA16(ua, bfr[nt], ((f32x4){0.f, 0.f, 0.f, 0.f}));
#pragma unroll
            for (int jj = 0; jj < 4; ++jj) BU[(fq * 4 + jj) * 132 + 16 * nt + fr] = bu[jj]; }
        LDS_WAIT();
#pragma unroll
        for (int t = 0; t < 16; ++t) {
            if (t < nv) {
                const f32x2 bu = *(const LAS f32x2*)(BU + t * 132 + 2 * lane);
                const float nr = lam[0] * xr - lam[1] * xi + bu[0], ni = lam[0] * xi + lam[1] * xr + bu[1];
                xr = nr; xi = ni;
            }
            if (FULL) *(LAS unsigned*)(Xs + t * 136 + 2 * lane) = cvt_pk_bf16(xr, xi);
        }
        LDS_WAIT();
        if (FULL) {
            f32x4 y = (f32x4){0.f, 0.f, 0.f, 0.f};
#pragma unroll
            for (int kk = 0; kk < 4; ++kk) { const bf16x8 a = *(const LAS bf16x8*)(Xs + fr * 136 + kk * 32 + fq * 8); y = MFMA32(a, cfr[kk], y); }
#pragma unroll
            for (int jj = 0; jj < 4; ++jj) { const int t = fq * 4 + jj;
                if (t < nv) { const size_t gi = (row0 + t0 + t) * D + g * 16 + fr; Y[gi] = f2bf(geluf_(y[jj] + dsk * bf2f(us[jj]))); } }
            LDS_WAIT();
        }
        ua = ua_n;
#pragma unroll
        for (int jj = 0; jj < 4; ++jj) us[jj] = us_n[jj];
    }
}
constexpr size_t WS_S5SEG_BYTES = (size_t)8 * 64 * S5_NSEG * 64 * 8;
__device__ __forceinline__ void phase_s5a(const Ctx& p, LAS unsigned char* lds) {
    const int tid = p.tid, lane = tid & 63, w = tid >> 6;
    LAS float* BU = (LAS float*)(lds + w * 12800); LAS u16* Xs = (LAS u16*)(lds + w * 12800 + 8448);
    f32x2* SEG = (f32x2*)(p.ws() + WS_KVB);
    const int gw = w * p.nb + p.bid, NGW = p.nb * 8;
    constexpr int NPA = 512 * (S5_NSEG - 1);
    for (int task = gw; task < NPA + 2048; task += NGW) {
        if (task < NPA) {
            const int bg = task / (S5_NSEG - 1), seg = task - bg * (S5_NSEG - 1), b = bg >> 6, g = bg & 63;
            float xr = 0.f, xi = 0.f;
            s5_run<false>(p, BU, Xs, g, (size_t)b * SEQ + seg * S5_SEGLEN, S5_SEGLEN, xr, xi, lane);
            SEG[((size_t)bg * S5_NSEG + seg) * 64 + lane] = (f32x2){xr, xi};
        } else {
            const int bg = task - NPA, b = bg >> 6, g = bg & 63;
            const f32x2 s0 = ((const f32x2*)p.in(6))[(size_t)bg * 64 + lane];
            float xr = s0[0], xi = s0[1];
            s5_run<true>(p, BU, Xs, g, (size_t)MP + b * 4, 4, xr, xi, lane);
            *(f32x2*)(p.out() + OUT_S5S + ((size_t)bg * 64 + lane) * 2) = (f32x2){xr, xi};
        }
    }
}
__device__ __forceinline__ void phase_s5c(const Ctx& p, LAS unsigned char* lds) {
    const int tid = p.tid, lane = tid & 63, w = tid >> 6;
    LAS float* BU = (LAS float*)(lds + w * 12800); LAS u16* Xs = (LAS u16*)(lds + w * 12800 + 8448);
    const f32x2* SEG = (const f32x2*)(p.ws() + WS_KVB);
    const int gw = w * p.nb + p.bid, NGW = p.nb * 8;
    for (int task = gw; task < 512 * S5_NSEG; task += NGW) {
        const int bg = task / S5_NSEG, seg = task - bg * S5_NSEG, b = bg >> 6, g = bg & 63;
        const f32x2 lam = ((const f32x2*)(p.ws() + WS_LAM))[g * 64 + lane];
        float pr = lam[0], pi = lam[1];
#pragma unroll
        for (int i = 0; i < 9; ++i) { const float nr = pr * pr - pi * pi, ni = 2.f * pr * pi; pr = nr; pi = ni; }
        float xr = 0.f, xi = 0.f;
        for (int s2 = 0; s2 < seg; ++s2) { const f32x2 e = SEG[((size_t)bg * S5_NSEG + s2) * 64 + lane]; const float nr = pr * xr - pi * xi + e[0], ni = pr * xi + pi * xr + e[1]; xr = nr; xi = ni; }
        s5_run<true>(p, BU, Xs, g, (size_t)b * SEQ + seg * S5_SEGLEN, S5_SEGLEN, xr, xi, lane);
        if (seg == S5_NSEG - 1) *(f32x2*)(p.out() + OUT_S5P + ((size_t)bg * 64 + lane) * 2) = (f32x2){xr, xi};
    }
}

#define XB_TMO      128
#define XB_XCNT(j)  (256  + 64 * (j))
#define XB_XSUB(j)  (1280 + 64 * (j))
#define XB_XGEN(j)  (2304 + 64 * (j))
#define XB_TOP      3328
#define XB_TOPGEN   3392
#define XCD_BAR_WORDS 3456
#define XB_SPIN_CAP (1u << 18)
__device__ __forceinline__ unsigned xb_ld(unsigned* p)              { return __hip_atomic_load(p, __ATOMIC_RELAXED, __HIP_MEMORY_SCOPE_AGENT); }
__device__ __forceinline__ unsigned xb_add(unsigned* p, unsigned v) { return __hip_atomic_fetch_add(p, v, __ATOMIC_RELAXED, __HIP_MEMORY_SCOPE_AGENT); }
__device__ __forceinline__ unsigned xb_xcc_id() { return (unsigned)__builtin_amdgcn_s_getreg((3 << 11) | 20) & 0xFu; }
#define XB_SPIN(cond, bar) do { unsigned _sp = 0; while (cond) { __builtin_amdgcn_s_sleep(1); \
    if ((++_sp & 255u) == 0u) { if (xb_ld(&(bar)[XB_TMO])) break; if (_sp > XB_SPIN_CAP) { atomicAdd(&(bar)[XB_TMO], 1u); break; } } } } while (0)
struct XcdBarrier { unsigned* bar; unsigned x; volatile LAS unsigned* st; };
__device__ __forceinline__ XcdBarrier xcd_barrier_post(unsigned* bar, volatile LAS unsigned* st) {
    XcdBarrier b; b.bar = bar; b.x = xb_xcc_id(); b.st = st;
    if (threadIdx.x == 0) (void)xb_add(&bar[XB_XCNT(b.x)], 1u);
    return b;
}
__device__ __forceinline__ void xcd_barrier_complete(unsigned* bar, unsigned x, unsigned& nloc, unsigned& nx) {
    const unsigned G = gridDim.x * gridDim.y * gridDim.z;
    unsigned sum, cnt, mine, sp = 0u;
    for (;;) {
        sum = 0u; cnt = 0u; mine = 0u;
#pragma unroll
        for (unsigned j = 0; j < 16; ++j) { const unsigned c = xb_ld(&bar[XB_XCNT(j)]); sum += c; cnt += (c > 0u) ? 1u : 0u; mine = (j == x) ? c : mine; }
        if (sum == G) break;
        __builtin_amdgcn_s_sleep(1);
        if ((++sp & 255u) == 0u) { if (xb_ld(&bar[XB_TMO])) break; if (sp > XB_SPIN_CAP) { atomicAdd(&bar[XB_TMO], 1u); break; } }
    }
    nloc = mine > 0u ? mine : 1u; nx = cnt > 0u ? cnt : 1u;
}
__device__ __forceinline__ void xcd_barrier(const XcdBarrier& b) {
    asm volatile("s_waitcnt vmcnt(0)" ::: "memory");
    __syncthreads();
    if (threadIdx.x == 0) {
        unsigned* bar = b.bar;
        __builtin_amdgcn_s_waitcnt(0);
        unsigned nloc = b.st[0], nx = b.st[1];
        if (nloc == 0u) { xcd_barrier_complete(bar, b.x, nloc, nx); b.st[0] = nloc; b.st[1] = nx; }
        const unsigned old = xb_add(&bar[XB_XSUB(b.x)], 1u);
        const unsigned gen = old / nloc;
        if (old + 1u == (gen + 1u) * nloc) {
            __builtin_amdgcn_fence(__ATOMIC_RELEASE, "agent");
            asm volatile("s_waitcnt vmcnt(0)" ::: "memory");
            const unsigned og = xb_add(&bar[XB_TOP], 1u);
            const unsigned tg = og / nx;
            if (og + 1u == (tg + 1u) * nx) xb_add(&bar[XB_TOPGEN], 1u);
            else XB_SPIN(xb_ld(&bar[XB_TOPGEN]) == tg, bar);
            __builtin_amdgcn_fence(__ATOMIC_ACQUIRE, "agent");
            xb_add(&bar[XB_XGEN(b.x)], 1u);
            asm volatile("s_waitcnt vmcnt(0)" ::: "memory");
        } else {
            XB_SPIN(xb_ld(&bar[XB_XGEN(b.x)]) == gen, bar);
            __builtin_amdgcn_fence(__ATOMIC_ACQUIRE, "agent");
            asm volatile("s_waitcnt vmcnt(0)" ::: "memory");
        }
    }
    __syncthreads();
}

__device__ __forceinline__ Ctx launder(LAS unsigned char* lds0, LAS unsigned char*& lds) {
    KargPtr kp = (KargPtr)__builtin_amdgcn_kernarg_segment_ptr();
    int z; asm volatile("s_mov_b32 %0, 0" : "=s"(z), "+s"(kp));
    lds = lds0 + z;
    int t = __builtin_amdgcn_workitem_id_x(), b = __builtin_amdgcn_workgroup_id_x(), n = (int)__builtin_amdgcn_grid_size_x() / 512;
    asm volatile("" : "+v"(t), "+s"(b), "+s"(n));
    Ctx c; c.kp = kp; c.tid = t; c.bid = b; c.nb = n;
    return c;
}
#define PH_BEGIN LAS unsigned char* lds; const Ctx p = launder(lds0, lds); unsigned char* ws = p.ws(); (void)ws; (void)lds;
constexpr int NPHASE = 24;
__global__ void __launch_bounds__(512, 2) mega(Params pp) {
    extern __shared__ __attribute__((aligned(16))) unsigned char shm[];
    LAS unsigned char* lds0 = (LAS unsigned char*)shm;
#if !MK_MULTI
    volatile LAS unsigned* xst = (volatile LAS unsigned*)(shm + LDS_BYTES - 16);
    if (threadIdx.x == 0) { xst[0] = 0u; xst[1] = 0u; }
    __syncthreads();
    const XcdBarrier xb = xcd_barrier_post((unsigned*)(pp.ws + WS_BAR), xst);
#define GRID_BAR(n) do { if ((n) == 0) cg::this_grid().sync(); else xcd_barrier(xb); } while (0)
#else
#define GRID_BAR(n) do { } while (0)
#endif
#if MK_MULTI
    const int ph_lo = pp.ph_lo, ph_hi = pp.ph_hi;
#else
    constexpr int ph_lo = 0, ph_hi = NPHASE;
#endif
#ifndef PH_MASK
#define PH_MASK 0xffffff
#endif
#define EN(n) (((PH_MASK) >> (n)) & 1)
#ifndef DUP_MASK
#define DUP_MASK 0
#endif
#ifndef EXTRA_SYNCS
#define EXTRA_SYNCS 0
#endif
#define DUPN(n) (((DUP_MASK) >> (n)) & 1)
#define PHASE(n, ...) if (EN(n) && ph_lo <= (n) && (n) < ph_hi) { PH_BEGIN __VA_ARGS__ } if (ph_lo <= (n) && (n) + 1 < ph_hi) GRID_BAR(n); \
    if (DUPN(n)) { { PH_BEGIN __VA_ARGS__ } GRID_BAR(1); }
#define HGRN_IN(j, kv) { EpiHgrnIn E; E.Q = (u16*)(ws + WS_Q); E.KK = (u16*)(ws + WS_K); E.V = (u16*)(ws + WS_V); E.GT = (u16*)(ws + WS_GT); E.G = (float*)(ws + WS_G); E.lb = (const float*)(ws + WS_LB) + (j) * 1024; E.SSQ = (const float*)(ws + WS_SSQ); \
        run_gemm(p, lds, (const u16*)(ws + WS_H), (const u16*)(ws + WS_WT_A_IN) + (size_t)(j) * 4096 * 1024, 4096, E, kv); }
#define RESID(wt, kv, fuse, nl, first) { EpiResidT<fuse, first> E; E.xin_p = p.in(0); E.xin_s = p.in(1); E.X = (float*)(ws + WS_X); E.H = (u16*)(ws + WS_H); E.wn = p.in(7) + (nl) * D; E.SSQ = (float*)(ws + WS_SSQ); run_gemm(p, lds, (const u16*)(ws + WS_O), (const u16*)(ws + (wt)), 1024, E, kv); }
#pragma unroll 1
    for (int i = 0; i < EXTRA_SYNCS; ++i) GRID_BAR(1);
    PHASE(0, phase_prep(p, lds);)
    PHASE(1, HGRN_IN(0, 0))
    PHASE(2, phase_hgrn_local(p, lds);)
    PHASE(3, phase_hgrn_scan(p, 0);)
    PHASE(4, phase_hgrn_out(p, lds, 0);)
    PHASE(5, RESID(WS_WT_A_OUT, 1, true, 1, true))
    PHASE(7, { EpiAttnIn E; E.Qg = (u16*)(ws + WS_Q); E.Kg = (u16*)(ws + WS_K); E.Vg = (u16*)(ws + WS_V); E.GT = (u16*)(ws + WS_GT); E.rcs = (const f32x2*)(ws + WS_RCS); E.out = p.out(); E.SSQ = (const float*)(ws + WS_SSQ);
            run_gemm(p, lds, (const u16*)(ws + WS_H), (const u16*)(ws + WS_WT_B_IN), 10240, E, 2); })
    PHASE(8, phase_attn(p, lds);)
    PHASE(9, phase_merge(p, lds);)
    PHASE(10, RESID(WS_WT_B_OUT, 3, true, 2, false))
    PHASE(12, { EpiS5In E; E.U = (u16*)(ws + WS_V); E.GT = (u16*)(ws + WS_GT); E.SSQ = (const float*)(ws + WS_SSQ); run_gemm(p, lds, (const u16*)(ws + WS_H), (const u16*)(ws + WS_WT_C_IN), 2048, E, 4); })
    PHASE(13, phase_s5a(p, lds);)
    PHASE(14, phase_s5c(p, lds);)
    PHASE(15, { EpiGlu E; E.Y = (const u16*)(ws + WS_OG); E.GT = (const u16*)(ws + WS_GT); E.bias = p.in(25); E.O = (u16*)(ws + WS_O);
            run_gemm(p, lds, (const u16*)(ws + WS_OG), (const u16*)(ws + WS_WT_C_GLU), 1024, E, 5); })
    PHASE(16, RESID(WS_WT_C_OUT, 6, true, 3, false))
    PHASE(18, HGRN_IN(1, 7))
    PHASE(19, phase_hgrn_local(p, lds);)
    PHASE(20, phase_hgrn_scan(p, 1);)
    PHASE(21, phase_hgrn_out(p, lds, 1);)
    PHASE(22, RESID(WS_WT_A_OUT + (size_t)1024 * 1024 * 2, 8, true, 0, false))
    PHASE(23, phase_final(p);)
}

extern "C" void kernel_launch(void* const* d_in, const int* in_sizes, int n_in, void* d_out, int out_size, void* d_ws, size_t ws_size, hipStream_t stream) {
    static int grid = 0;
    if (grid == 0) {
        if (n_in != 27 || (size_t)out_size != OUT_END || ws_size < WS_END) { fprintf(stderr, "kernel_launch: unexpected shapes n_in %d out %d ws %zu (need %zu)\n", n_in, out_size, ws_size, (size_t)WS_END); grid = -1; return; }
        int dev = 0, cus = 0, per_cu = 0;
        hipGetDevice(&dev); hipDeviceGetAttribute(&cus, hipDeviceAttributeMultiprocessorCount, dev);
        if (hipFuncSetAttribute((const void*)mega, hipFuncAttributeMaxDynamicSharedMemorySize, LDS_BYTES) != hipSuccess) { fprintf(stderr, "kernel_launch: hipFuncSetAttribute failed\n"); grid = -1; return; }
        if (hipOccupancyMaxActiveBlocksPerMultiprocessor(&per_cu, (const void*)mega, 512, LDS_BYTES) != hipSuccess || per_cu < 1) { fprintf(stderr, "kernel_launch: occupancy query gave %d\n", per_cu); per_cu = 1; }
        (void)hipGetLastError();
        grid = cus * per_cu;
    }
    if (grid < 0) return;
    Params p{};
    for (int i = 0; i < 27; ++i) p.in[i] = (const float*)d_in[i];
    p.out = (float*)d_out; p.ws = (unsigned char*)d_ws;
#if MK_MULTI
    for (int ph = 0; ph < NPHASE; ++ph) { p.ph_lo = ph; p.ph_hi = ph + 1; hipLaunchKernelGGL(mega, dim3(grid), dim3(512), LDS_BYTES, stream, p); }
#else
    p.ph_lo = 0; p.ph_hi = NPHASE;
    (void)hipMemsetAsync((unsigned char*)d_ws + WS_BAR, 0, 16384, stream);
    void* args[] = {&p};
    hipError_t e = hipLaunchCooperativeKernel((const void*)mega, dim3(grid), dim3(512), args, LDS_BYTES, stream);
    if (e != hipSuccess) fprintf(stderr, "cooperative launch failed: %s (grid %d)\n", hipGetErrorString(e), grid);
#endif
}
```
